# Optimizing an MI355X kernel written in HIP

```python
import math
import jax, jax.numpy as jnp
from jax import lax
import numpy as np

D_MODEL = 1024
BATCH = 4
SEQ = 8192
DEPTH = 1

D_MIX = D_MODEL
CONV_CH = D_MIX // 2
CONV_GROUPS = 8
CONV_WIDTH = 31
SB_HEADS = 8
SB_HEAD_DIM = 64
SB_WIDTH = SB_HEADS * SB_HEAD_DIM
Q_BLOCK = 128
D_FF = int(math.ceil((8 * D_MODEL / 3) / 256) * 256)
IN_COLS = 2 * CONV_CH + 3 * SB_WIDTH
EPS = 1e-6

kernel_name = "hymba_conformer_stickbreaking_sandwich"


def _rmsnorm(x, g):
    xf = x.astype(jnp.float32)
    y = xf * lax.rsqrt(jnp.mean(xf * xf, axis=-1, keepdims=True) + EPS)
    return (y * g.astype(jnp.float32)).astype(x.dtype)


def _layernorm(x, g, b):
    xf = x.astype(jnp.float32)
    mu = jnp.mean(xf, axis=-1, keepdims=True)
    var = jnp.mean(jnp.square(xf - mu), axis=-1, keepdims=True)
    y = (xf - mu) * lax.rsqrt(var + EPS)
    return (y * g.astype(jnp.float32) + b.astype(jnp.float32)).astype(x.dtype)


def _conformer_conv(val, gate, conv_w, conv_b, ln_g, ln_b):
    glu = val * jax.nn.sigmoid(gate)
    padded = jnp.pad(glu, ((0, 0), (CONV_WIDTH - 1, 0), (0, 0)))
    y = lax.conv_general_dilated(
        padded, conv_w.astype(glu.dtype), window_strides=(1,), padding="VALID",
        dimension_numbers=("NWC", "WIO", "NWC"), feature_group_count=CONV_CH)
    y = y + conv_b
    y = _layernorm(y, ln_g, ln_b)
    return jax.nn.silu(y)


def _stick_breaking(q, k, v):
    B, S = q.shape[0], q.shape[1]
    scale = 1.0 / math.sqrt(SB_HEAD_DIM)
    qh = jnp.transpose(q, (0, 2, 1, 3))
    kh = jnp.transpose(k, (0, 2, 1, 3))
    vh = jnp.transpose(v, (0, 2, 1, 3))
    nb = S // Q_BLOCK
    q_blocks = jnp.transpose(qh.reshape(B, SB_HEADS, nb, Q_BLOCK, SB_HEAD_DIM), (2, 0, 1, 3, 4))
    starts = jnp.arange(nb, dtype=jnp.int32) * Q_BLOCK
    key_pos = jnp.arange(S, dtype=jnp.int32)

    def one_block(args):
        qb, t0 = args
        z = jnp.einsum("bhqd,bhkd->bhqk", qb, kh,
                       preferred_element_type=jnp.float32) * scale
        q_pos = t0 + jnp.arange(Q_BLOCK, dtype=jnp.int32)
        mask = key_pos[None, :] < q_pos[:, None]
        log_beta = jax.nn.log_sigmoid(z)
        log_1m_beta = jnp.where(mask, jax.nn.log_sigmoid(-z), 0.0)
        between = lax.cumsum(log_1m_beta, axis=3, reverse=True) - log_1m_beta
        attn = jnp.where(mask, jnp.exp(log_beta + between), 0.0)
        return jnp.einsum("bhqk,bhkd->bhqd", attn.astype(vh.dtype), vh)

    out = lax.map(one_block, (q_blocks, starts))
    out = jnp.transpose(out, (1, 0, 3, 2, 4))
    return out.reshape(B, S, SB_HEADS, SB_HEAD_DIM)


def setup_inputs(seed: int = 0) -> dict:
    key = jax.random.key(seed)
    ks = jax.random.split(key, 16)
    nrm = jax.random.normal
    def gain(k, shape):
        return 1.0 + 0.05 * nrm(k, shape, jnp.float32)
    return {
        "x": nrm(ks[0], (BATCH, SEQ, D_MODEL), jnp.float32),
        "g_pre_mix": gain(ks[1], (DEPTH, D_MODEL)),
        "w_in": nrm(ks[2], (DEPTH, D_MODEL, IN_COLS), jnp.float32) * D_MODEL ** -0.5,
        "conv_w": nrm(ks[3], (DEPTH, CONV_WIDTH, 1, CONV_CH), jnp.float32) * CONV_WIDTH ** -0.5,
        "conv_b": 0.02 * nrm(ks[4], (DEPTH, CONV_CH), jnp.float32),
        "conv_ln_g": gain(ks[5], (DEPTH, CONV_CH)),
        "conv_ln_b": 0.02 * nrm(ks[6], (DEPTH, CONV_CH), jnp.float32),
        "attn_norm_g": gain(ks[7], (DEPTH, SB_HEADS, SB_HEAD_DIM)),
        "w_out": nrm(ks[8], (DEPTH, D_MIX, D_MODEL), jnp.float32) * D_MIX ** -0.5,
        "g_post_mix": gain(ks[9], (DEPTH, D_MODEL)),
        "g_pre_ffn": gain(ks[10], (DEPTH, D_MODEL)),
        "w_gate": nrm(ks[11], (DEPTH, D_MODEL, D_FF), jnp.float32) * D_MODEL ** -0.5,
        "w_up": nrm(ks[12], (DEPTH, D_MODEL, D_FF), jnp.float32) * D_MODEL ** -0.5,
        "w_down": nrm(ks[13], (DEPTH, D_FF, D_MODEL), jnp.float32) * D_FF ** -0.5,
        "g_post_ffn": gain(ks[14], (DEPTH, D_MODEL)),
    }


def reference(x, g_pre_mix, w_in, conv_w, conv_b, conv_ln_g, conv_ln_b, attn_norm_g,
              w_out, g_post_mix, g_pre_ffn, w_gate, w_up, w_down, g_post_ffn):
    B, S, _ = x.shape
    h = x
    for l in range(DEPTH):
        a = _rmsnorm(h, g_pre_mix[l])
        u = jnp.einsum("bsd,dc->bsc", a, w_in[l])
        c_val = u[..., :CONV_CH]
        c_gate = u[..., CONV_CH:2 * CONV_CH]
        qkv = u[..., 2 * CONV_CH:].reshape(B, S, 3, SB_HEADS, SB_HEAD_DIM)
        conv_out = _conformer_conv(c_val, c_gate, conv_w[l], conv_b[l], conv_ln_g[l], conv_ln_b[l])
        attn_out = _stick_breaking(qkv[:, :, 0], qkv[:, :, 1], qkv[:, :, 2])
        attn_out = _rmsnorm(attn_out, attn_norm_g[l]).reshape(B, S, SB_WIDTH)
        mixed = jnp.concatenate([conv_out, attn_out], axis=-1)
        y = jnp.einsum("bsc,cd->bsd", mixed, w_out[l])
        h = h + _rmsnorm(y, g_post_mix[l])
        f_in = _rmsnorm(h, g_pre_ffn[l])
        gt = jnp.einsum("bsd,df->bsf", f_in, w_gate[l])
        up = jnp.einsum("bsd,df->bsf", f_in, w_up[l])
        f = jnp.einsum("bsf,fd->bsd", jax.nn.silu(gt) * up, w_down[l])
        h = h + _rmsnorm(f, g_post_ffn[l])
    return h
```

```cpp
#include <hip/hip_runtime.h>
#include <hip/hip_cooperative_groups.h>
#include <cstdio>
#include <cstdint>
namespace cg = cooperative_groups;
namespace pg8 {
#define PG8_LAS __attribute__((address_space(3)))
typedef unsigned short bf16_t;
typedef short bf16x8 __attribute__((ext_vector_type(8)));
typedef float f32x4 __attribute__((ext_vector_type(4)));
typedef unsigned u32x4 __attribute__((ext_vector_type(4)));
constexpr int BM = 256, BK = 64, HALF = 128, HTB = HALF * BK * 2  , STAGE_BYTES = 8 * HTB, NXCD = 8, WGM = 8;

__host__ __device__ __forceinline__ int lds_byte(int r, int c) { const int st = (r >> 4) * 2 + (c >> 5), rr = r & 15, cc = c & 31, ob = rr * 64 + cc * 2; return st * 1024 + (ob ^ (((ob >> 9) & 1) << 5)); }
__host__ __device__ __forceinline__ void stage_rc(int b, int& R, int& C) { const int st = b / 1024, sb = b % 1024, swz = sb ^ (((sb >> 9) & 1) << 5); R = (st >> 1) * 16 + swz / 64; C = (st & 1) * 32 + (swz % 64) / 2; }
__host__ __device__ __forceinline__ int perm32(int rho) { const int n = rho >> 4, i = rho & 15; return 8 * (i >> 2) + 4 * n + (i & 3); }

struct Unit { int pm, pn; };
struct Gemm { const bf16_t* A; const bf16_t* Bt; int M, N, K; };

struct StaticOrder {
    int nM, nN, nwg, G, c;
    __host__ __device__ void init(int M, int N, int G_, int c_) { nM = M / BM; nN = N / BM; nwg = nM * nN; G = G_; c = c_; }
    __host__ __device__ bool next(int i, Unit& u) const {
        const long L = (long)i * G + c; if (L >= nwg) return false;
        int wgid = (int)L; { const int q = nwg / NXCD, r = nwg % NXCD, xcd = wgid % NXCD, off = wgid / NXCD; wgid = (xcd < r ? xcd * (q + 1) : r * (q + 1) + (xcd - r) * q) + off; }
        const int nig = WGM * nN, gid = wgid / nig, fm = gid * WGM, gsz = (nM - fm) < WGM ? (nM - fm) : WGM;
        u.pm = fm + ((wgid % nig) % gsz); u.pn = (wgid % nig) / gsz; return true;
    }
    __device__ __forceinline__ void a_ready(const Unit&) const {}
    __device__ __forceinline__ void done(const Unit&) const {}
};

struct EpiInShift { static constexpr int VT_PM = 40, VT_PN = 48; };
struct OrderIn {
    int G, c;
    static constexpr int NA = 128 * 8, NB = 2 * 128;
    __host__ __device__ static void map_tile(int L, int nM, int nN, Unit& u) {
        const int nwg = nM * nN; int wgid = L; { const int q = nwg / NXCD, r = nwg % NXCD, xcd = wgid % NXCD, off = wgid / NXCD; wgid = (xcd < r ? xcd * (q + 1) : r * (q + 1) + (xcd - r) * q) + off; }
        const int nig = WGM * nN, gid = wgid / nig, fm = gid * WGM, gsz = (nM - fm) < WGM ? (nM - fm) : WGM;
        u.pm = fm + ((wgid % nig) % gsz); u.pn = (wgid % nig) / gsz;
    }
    __host__ __device__ bool next(int i, Unit& u) const {
        const long L = (long)i * G + c;
        if (L < NA) { map_tile((int)L, 128, 8, u); return true; }
        if (L < NA + NB) { map_tile((int)L - NA, 2, 128, u); u.pm -= EpiInShift::VT_PM; u.pn += EpiInShift::VT_PN; return true; }
        return false;
    }
    __device__ __forceinline__ void a_ready(const Unit&) const {}
    __device__ __forceinline__ void done(const Unit&) const {}
};

__device__ __forceinline__ unsigned cvt_pk_bf16(float lo, float hi) { unsigned r; asm volatile("v_cvt_pk_bf16_f32 %0, %1, %2" : "=v"(r) : "v"(lo), "v"(hi)); return r; }
typedef float f32x2 __attribute__((ext_vector_type(2)));
__device__ __forceinline__ f32x2 gelu_pk(f32x2 v) {
    const f32x2 av = __builtin_elementwise_abs(v), d = av * 0.2316418882f + 1.0f;
    f32x2 t; t.x = __builtin_amdgcn_rcpf(d.x); t.y = __builtin_amdgcn_rcpf(d.y);
    f32x2 q = t * 0.5307027145f + (-0.7265760135f); q = q * t + 0.7107068705f; q = q * t + (-0.142248368f); q = q * t + 0.127414796f; q = q * t;
    const f32x2 s = (v * v) * (-0.72134752044f);
    f32x2 e; e.x = __builtin_amdgcn_exp2f(s.x); e.y = __builtin_amdgcn_exp2f(s.y);
    const f32x2 m = v * (q * e), r = v - m;
    f32x2 o; o.x = v.x < 0.f ? m.x : r.x; o.y = v.y < 0.f ? m.y : r.y; return o;
}

template <int ACT  > struct EpiBf16 {
    static constexpr bool PERM = true, AFTER_DRAIN = false; static_assert(ACT == 0 || ACT == 1, "EpiBf16: ACT is 0 (none) or 1 (gelu_pk)");
    bf16_t* O; int ldc; const float* bias; int split_cols; size_t split_stride; float scale0;
    __device__ __forceinline__ void operator()(const f32x4 (&acc)[2][2][4][2], const Unit& u, int wr, int wc, int fr, int fq) const {
        const int row0 = u.pm * BM + wr * 64 + fr; int colt = u.pn * BM; bf16_t* base = O;
        float sc = 1.f; if (split_cols) { const int t = colt / split_cols; base += (size_t)t * split_stride; colt -= t * split_cols; if (t == 0) sc = scale0; }
        const int col0 = colt + wc * 32 + 8 * fq, bcol0 = u.pn * BM + wc * 32 + 8 * fq;
        f32x4 bv[2][2];
#pragma unroll
        for (int bj = 0; bj < 2; ++bj)
#pragma unroll
            for (int n = 0; n < 2; ++n) bv[bj][n] = bias ? *(const f32x4*)(bias + bcol0 + bj * HALF + 4 * n) : (f32x4){0.f, 0.f, 0.f, 0.f};
#pragma unroll
        for (int ai = 0; ai < 2; ++ai)
#pragma unroll
            for (int m = 0; m < 4; ++m) { bf16_t* rowp = base + (size_t)(row0 + ai * HALF + m * 16) * ldc + col0;
#pragma unroll
                for (int bj = 0; bj < 2; ++bj) { f32x4 v0 = acc[ai][bj][m][0] + bv[bj][0], v1 = acc[ai][bj][m][1] + bv[bj][1];
                    if (ACT == 1) { f32x2 a = gelu_pk((f32x2){v0[0], v0[1]}), b = gelu_pk((f32x2){v0[2], v0[3]}), c = gelu_pk((f32x2){v1[0], v1[1]}), d = gelu_pk((f32x2){v1[2], v1[3]});
                        v0 = (f32x4){a.x, a.y, b.x, b.y}; v1 = (f32x4){c.x, c.y, d.x, d.y}; }
                    v0 = v0 * sc; v1 = v1 * sc; u32x4 w; w.x = cvt_pk_bf16(v0[0], v0[1]); w.y = cvt_pk_bf16(v0[2], v0[3]); w.z = cvt_pk_bf16(v1[0], v1[1]); w.w = cvt_pk_bf16(v1[2], v1[3]);
                    *(u32x4*)(rowp + bj * HALF) = w; } }
    }
};

__device__ __forceinline__ float sigm(float x) { return __builtin_amdgcn_rcpf(1.0f + __builtin_amdgcn_exp2f(-1.4426950408889634f * x)); }
template <int MODE> struct EpiGate {
    static constexpr bool PERM = true, AFTER_DRAIN = false;
    bf16_t* O; int ldc;
    __device__ __forceinline__ void store(const f32x4 (&acc)[2][2][4][2], const Unit& u, int wr, int wc, int fr, int fq) const {
        const int row0 = u.pm * BM + wr * 64 + fr, col0 = u.pn * HALF + wc * 32 + 8 * fq;
#pragma unroll
        for (int ai = 0; ai < 2; ++ai)
#pragma unroll
            for (int m = 0; m < 4; ++m) { bf16_t* rowp = O + (size_t)(row0 + ai * HALF + m * 16) * ldc + col0;
                f32x4 r0, r1;
#pragma unroll
                for (int i = 0; i < 4; ++i) {
                    const float a00 = acc[ai][0][m][0][i], a01 = acc[ai][0][m][1][i], a10 = acc[ai][1][m][0][i], a11 = acc[ai][1][m][1][i];
                    if (MODE == 0) { r0[i] = a00 * sigm(a10); r1[i] = a01 * sigm(a11); }
                    else           { r0[i] = a00 * sigm(a00) * a10; r1[i] = a01 * sigm(a01) * a11; } }
                u32x4 w; w.x = cvt_pk_bf16(r0[0], r0[1]); w.y = cvt_pk_bf16(r0[2], r0[3]); w.z = cvt_pk_bf16(r1[0], r1[1]); w.w = cvt_pk_bf16(r1[2], r1[3]);
                *(u32x4*)rowp = w; }
    }
    __device__ __forceinline__ void operator()(const f32x4 (&acc)[2][2][4][2], const Unit& u, int wr, int wc, int fr, int fq) const { store(acc, u, wr, wc, fr, fq); }
};
struct EpiIn {
    static constexpr bool PERM = true, AFTER_DRAIN = false;
    bf16_t* GLU; bf16_t* QK; bf16_t* VT; int ldvt;
    static constexpr int VT_PM = 40, VT_PN = 48;
    __device__ __forceinline__ void operator()(const f32x4 (&acc)[2][2][4][2], const Unit& u, int wr, int wc, int fr, int fq) const {
        if (u.pn < 4) { EpiGate<0> g{GLU, 512}; g.store(acc, u, wr, wc, fr, fq); }
        else {
            const bool vt = u.pn >= VT_PN;
            const int row0 = (vt ? u.pm + VT_PM : u.pm) * BM + wr * 64 + fr, col0 = (vt ? u.pn - VT_PN : u.pn - 4) * BM + wc * 32 + 8 * fq;
            bf16_t* const OB = vt ? VT : QK; const size_t ld = vt ? (size_t)ldvt : (size_t)1024;
#pragma unroll
            for (int ai = 0; ai < 2; ++ai)
#pragma unroll
                for (int m = 0; m < 4; ++m) { bf16_t* rowp = OB + (size_t)(row0 + ai * HALF + m * 16) * ld + col0;
#pragma unroll
                    for (int bj = 0; bj < 2; ++bj) { const f32x4 v0 = acc[ai][bj][m][0], v1 = acc[ai][bj][m][1];
                        u32x4 w; w.x = cvt_pk_bf16(v0[0], v0[1]); w.y = cvt_pk_bf16(v0[2], v0[3]); w.z = cvt_pk_bf16(v1[0], v1[1]); w.w = cvt_pk_bf16(v1[2], v1[3]);
                        *(u32x4*)(rowp + bj * HALF) = w; } }
        }
    }
};
struct EpiF32 {
    static constexpr bool PERM = false, AFTER_DRAIN = false;
    float* C; int ldc;
    __device__ __forceinline__ void operator()(const f32x4 (&acc)[2][2][4][2], const Unit& u, int wr, int wc, int fr, int fq) const {
        const int col0 = u.pn * BM + wc * 32 + 4 * fq;
#pragma unroll
        for (int ai = 0; ai < 2; ++ai)
#pragma unroll
            for (int m = 0; m < 4; ++m) { float* rowp = C + (size_t)(u.pm * BM + ai * HALF + wr * 64 + m * 16 + fr) * ldc + col0;
#pragma unroll
                for (int bj = 0; bj < 2; ++bj)
#pragma unroll
                    for (int n = 0; n < 2; ++n) *(f32x4*)(rowp + bj * HALF + n * 16) = acc[ai][bj][m][n]; }
    }
};

template <class Epi, class Sched, bool ALIGN_EPI = false, bool SP2 = false>
__device__ __forceinline__ void gemm_phase(PG8_LAS unsigned char* lds, const Gemm g, const Sched& S, const Epi& E) {
    const int tid = threadIdx.x, wid = __builtin_amdgcn_readfirstlane(tid >> 6), lane = tid & 63, wr = wid >> 2, wc = wid & 3, fr = lane & 15, fq = lane >> 4;
    const int K = g.K, nt = K / BK;
    unsigned voffA[2], voffB[2];
#pragma unroll
    for (int i = 0; i < 2; ++i) { int R, C; stage_rc(tid * 16 + i * 8192, R, C); const int Rb = Epi::PERM ? ((R & ~31) + perm32(R & 31)) : R;
        voffA[i] = (unsigned)(R * K + C) * 2u; voffB[i] = (unsigned)(Rb * K + C) * 2u; }
    const size_t kstep = (size_t)(BK * 2);
    const size_t hstep = (size_t)HALF * K * 2;
    const size_t tstep = 2 * hstep;
    const unsigned ldsw = (unsigned)wid * 1024u;
    const int aoff = lds_byte(wr * 64 + fr, fq * 8), boff = lds_byte(wc * 32 + fr, fq * 8);
#define PG8_SA(b, h) (((b) * 2 + (h)) * HTB)
#define PG8_SB(b, h) ((4 + (b) * 2 + (h)) * HTB)
#define PG8_STAGE(bufoff, gbase, voff) do { _Pragma("unroll") for (int _i = 0; _i < 2; ++_i) \
        __builtin_amdgcn_global_load_lds((const unsigned*)((const char*)(gbase) + (voff)[_i]), (PG8_LAS unsigned*)(lds + (bufoff) + ldsw + _i * 8192), 16, 0, 0); } while (0)
#define PG8_LDA(dst, b, h) do { _Pragma("unroll") for (int m = 0; m < 4; ++m) _Pragma("unroll") for (int k = 0; k < 2; ++k) dst[m][k] = *(const PG8_LAS bf16x8*)(lds + PG8_SA(b, h) + aoff + m * 2048 + k * 1024); } while (0)
#define PG8_LDB(dst, b, h) do { _Pragma("unroll") for (int n = 0; n < 2; ++n) _Pragma("unroll") for (int k = 0; k < 2; ++k) dst[n][k] = *(const PG8_LAS bf16x8*)(lds + PG8_SB(b, h) + boff + n * 2048 + k * 1024); } while (0)
#define PG8_MMA(ai, bj, At, Bt) do { __builtin_amdgcn_s_setprio(1); _Pragma("unroll") for (int m = 0; m < 4; ++m) _Pragma("unroll") for (int n = 0; n < 2; ++n) _Pragma("unroll") for (int k = 0; k < 2; ++k) \
        acc[ai][bj][m][n] = __builtin_amdgcn_mfma_f32_16x16x32_bf16(Bt[n][k], At[m][k], acc[ai][bj][m][n], 0, 0, 0); __builtin_amdgcn_s_setprio(0); } while (0)
#define PG8_WAIT_V(n) asm volatile("s_waitcnt vmcnt(" #n ")" ::: "memory")
#define PG8_WAIT_L(n) asm volatile("s_waitcnt lgkmcnt(" #n ")" ::: "memory")
#define PG8_BAR __builtin_amdgcn_s_barrier()
#define PG8_SCHED __builtin_amdgcn_sched_barrier(0)
    Unit cur, nxt; int ui = 0;
    if (!S.next(0, cur)) return;
    f32x4 acc[2][2][4][2];
#pragma unroll
    for (int a = 0; a < 2; ++a)
#pragma unroll
        for (int b = 0; b < 2; ++b)
#pragma unroll
            for (int m = 0; m < 4; ++m)
#pragma unroll
                for (int n = 0; n < 2; ++n) acc[a][b][m][n] = (f32x4){0.f, 0.f, 0.f, 0.f};
    bf16x8 At[4][2], B0[2][2], B1[2][2];
    const char* cA = (const char*)g.A + (size_t)cur.pm * tstep; const char* cB = (const char*)g.Bt + (size_t)cur.pn * tstep;
    S.a_ready(cur);
    if constexpr (SP2) {
        PG8_STAGE(PG8_SB(0, 0), cB, voffB); PG8_STAGE(PG8_SB(0, 1), cB + hstep, voffB); PG8_STAGE(PG8_SA(0, 0), cA, voffA); PG8_STAGE(PG8_SA(0, 1), cA + hstep, voffA);
        if (wr == 1) PG8_BAR;
        PG8_WAIT_V(2); PG8_BAR;
        PG8_STAGE(PG8_SB(1, 0), cB + kstep, voffB); PG8_STAGE(PG8_SA(1, 0), cA + kstep, voffA); PG8_STAGE(PG8_SB(1, 1), cB + hstep + kstep, voffB);
        PG8_WAIT_V(6); PG8_BAR;
    } else {
        PG8_STAGE(PG8_SB(0, 0), cB, voffB); PG8_STAGE(PG8_SA(0, 0), cA, voffA); PG8_STAGE(PG8_SB(0, 1), cB + hstep, voffB); PG8_STAGE(PG8_SA(0, 1), cA + hstep, voffA);
        if (wr == 1) PG8_BAR;
        PG8_WAIT_V(4); PG8_BAR;
        PG8_STAGE(PG8_SB(1, 0), cB + kstep, voffB); PG8_STAGE(PG8_SA(1, 0), cA + kstep, voffA); PG8_STAGE(PG8_SB(1, 1), cB + hstep + kstep, voffB);
        PG8_WAIT_V(6); PG8_BAR;
    }
    for (;;) {
        const bool has_next = S.next(ui + 1, nxt);
        const char* nA = has_next ? (const char*)g.A + (size_t)nxt.pm * tstep : cA; const char* nB = has_next ? (const char*)g.Bt + (size_t)nxt.pn * tstep : cB;
        for (int t = 0; t < nt; t += 2) {
            const bool last = (t == nt - 2);
            const char* a1 = cA + (size_t)(t + 1) * kstep;
            const char* a2 = last ? nA : cA + (size_t)(t + 2) * kstep; const char* b2 = last ? nB : cB + (size_t)(t + 2) * kstep;
            const char* a3 = a2 + kstep; const char* b3 = b2 + kstep;
            if (last && has_next) S.a_ready(nxt);
            if constexpr (SP2) {
            PG8_LDB(B0, 0, 0); PG8_LDB(B1, 0, 1); PG8_SCHED; PG8_LDA(At, 0, 0); PG8_STAGE(PG8_SA(1, 1), a1 + hstep, voffA);
            PG8_WAIT_V(8); PG8_WAIT_L(0); PG8_BAR; PG8_MMA(0, 0, At, B0); PG8_MMA(0, 1, At, B1); PG8_BAR; PG8_SCHED;
            PG8_LDA(At, 0, 1); PG8_STAGE(PG8_SB(0, 0), b2, voffB); PG8_STAGE(PG8_SB(0, 1), b2 + hstep, voffB); PG8_STAGE(PG8_SA(0, 0), a2, voffA);
            PG8_WAIT_V(8); PG8_WAIT_L(0); PG8_BAR; PG8_MMA(1, 0, At, B0); PG8_MMA(1, 1, At, B1); PG8_BAR; PG8_SCHED;
            PG8_LDB(B0, 1, 0); PG8_LDB(B1, 1, 1); PG8_SCHED; PG8_LDA(At, 1, 0); PG8_STAGE(PG8_SA(0, 1), a2 + hstep, voffA);
            PG8_WAIT_V(8); PG8_WAIT_L(0); PG8_BAR; PG8_MMA(0, 0, At, B0); PG8_MMA(0, 1, At, B1); PG8_BAR; PG8_SCHED;
            PG8_LDA(At, 1, 1); PG8_STAGE(PG8_SB(1, 0), b3, voffB); PG8_STAGE(PG8_SB(1, 1), b3 + hstep, voffB); PG8_STAGE(PG8_SA(1, 0), a3, voffA);
            PG8_WAIT_V(8); PG8_WAIT_L(0); PG8_BAR; PG8_MMA(1, 0, At, B0); PG8_MMA(1, 1, At, B1); PG8_BAR; PG8_SCHED;
            } else {
            PG8_LDB(B0, 0, 0); PG8_SCHED; PG8_LDA(At, 0, 0); PG8_STAGE(PG8_SA(1, 1), a1 + hstep, voffA);
            PG8_WAIT_L(8); PG8_BAR; PG8_WAIT_L(0); PG8_MMA(0, 0, At, B0); PG8_BAR; PG8_SCHED;
            PG8_LDB(B1, 0, 1); PG8_STAGE(PG8_SB(0, 0), b2, voffB);
            PG8_BAR; PG8_WAIT_L(0); PG8_MMA(0, 1, At, B1); PG8_BAR;
            PG8_LDA(At, 0, 1); PG8_STAGE(PG8_SA(0, 0), a2, voffA);
            PG8_BAR; PG8_WAIT_L(0); PG8_MMA(1, 0, At, B0); PG8_BAR; PG8_SCHED;
            PG8_STAGE(PG8_SB(0, 1), b2 + hstep, voffB);
            PG8_WAIT_V(6); PG8_BAR; PG8_MMA(1, 1, At, B1); PG8_BAR;
            PG8_LDB(B0, 1, 0); PG8_SCHED; PG8_LDA(At, 1, 0); PG8_STAGE(PG8_SA(0, 1), a2 + hstep, voffA);
            PG8_WAIT_L(8); PG8_BAR; PG8_WAIT_L(0); PG8_MMA(0, 0, At, B0); PG8_BAR; PG8_SCHED;
            PG8_LDB(B1, 1, 1); PG8_STAGE(PG8_SB(1, 0), b3, voffB);
            PG8_BAR; PG8_WAIT_L(0); PG8_MMA(0, 1, At, B1); PG8_BAR;
            PG8_LDA(At, 1, 1); PG8_STAGE(PG8_SA(1, 0), a3, voffA);
            PG8_BAR; PG8_WAIT_L(0); PG8_MMA(1, 0, At, B0); PG8_BAR; PG8_SCHED;
            PG8_STAGE(PG8_SB(1, 1), b3 + hstep, voffB);
            PG8_WAIT_V(6); PG8_BAR; PG8_MMA(1, 1, At, B1); PG8_BAR;
            }
        }
        if constexpr (ALIGN_EPI) { if (wr == 0) PG8_BAR; }
        if constexpr (!Epi::AFTER_DRAIN) { E(acc, cur, wr, wc, fr, fq); S.done(cur); }
        if (!has_next) break;
#pragma unroll
        for (int a = 0; a < 2; ++a)
#pragma unroll
            for (int b = 0; b < 2; ++b)
#pragma unroll
                for (int m = 0; m < 4; ++m)
#pragma unroll
                    for (int n = 0; n < 2; ++n) acc[a][b][m][n] = (f32x4){0.f, 0.f, 0.f, 0.f};
        cur = nxt; cA = nA; cB = nB; ++ui;
        if constexpr (ALIGN_EPI) { if (wr == 1) PG8_BAR; }
    }
    PG8_WAIT_V(0);
    if constexpr (!ALIGN_EPI) { if (wr == 0) PG8_BAR; }
    PG8_BAR;
    if constexpr (Epi::AFTER_DRAIN) { E.fused(acc, cur, wr, wc, fr, fq, lds, wid, lane); S.done(cur); }
#undef PG8_SA
#undef PG8_SB
#undef PG8_STAGE
#undef PG8_LDA
#undef PG8_LDB
#undef PG8_MMA
#undef PG8_WAIT_V
#undef PG8_WAIT_L
#undef PG8_BAR
#undef PG8_SCHED
}
}

#define GAS __attribute__((address_space(1)))
#define LAS __attribute__((address_space(3)))
typedef unsigned short bf16;
typedef unsigned v4u __attribute__((ext_vector_type(4)));
typedef unsigned v2u __attribute__((ext_vector_type(2)));
typedef float f32x4 __attribute__((ext_vector_type(4)));
typedef float f32x16 __attribute__((ext_vector_type(16)));
typedef short bf16x8 __attribute__((ext_vector_type(8)));
typedef short s16x4 __attribute__((ext_vector_type(4)));
typedef float f32x2_t __attribute__((ext_vector_type(2)));
typedef __bf16 bf16x2_t __attribute__((ext_vector_type(2)));

constexpr int NWAVES = 8;
constexpr int BATCH = 4, SEQ = 8192, D = 1024, M = BATCH * SEQ;
constexpr int CONV_CH = 512, CONV_W = 31, NH = 8, HD = 64, FF = 2816, IN_COLS = 2560;
constexpr float EPS = 1e-6f;
constexpr float LOG2E = 1.4426950408889634f;

constexpr size_t MiB = 1u << 20;
constexpr size_t WS_WIN = 0, WS_WOUT = 5 * MiB, WS_WGU = 7 * MiB, WS_WD = 18 * MiB;
constexpr size_t WS_XN = 24 * MiB;
constexpr size_t WS_Y = 88 * MiB;
constexpr size_t WS_GLU = 216 * MiB;
constexpr size_t WS_QK = 248 * MiB;
constexpr size_t WS_VT = 312 * MiB;
constexpr size_t WS_MIX = 344 * MiB;
constexpr size_t WS_ACT = 216 * MiB;
constexpr size_t WS_CTL = 408 * MiB, CTL_BYTES = 16384;
constexpr size_t WS_R1 = 409 * MiB;
constexpr size_t WS_END = 410 * MiB;
static_assert(WS_ACT + (size_t)M * FF * 2 <= WS_END && WS_MIX + (size_t)M * D * 2 <= WS_END && WS_WD + (size_t)D * FF * 2 <= WS_XN, "ws map");

constexpr int LDS_BYTES = 147456;

__device__ __forceinline__ unsigned cvtpk(float lo, float hi) { f32x2_t v = {lo, hi}; bf16x2_t b = __builtin_convertvector(v, bf16x2_t); return __builtin_bit_cast(unsigned, b); }
__device__ __forceinline__ float bf_lo(unsigned u) { return __builtin_bit_cast(float, u << 16); }
__device__ __forceinline__ float bf_hi(unsigned u) { return __builtin_bit_cast(float, u & 0xffff0000u); }
template <int CTRL> __device__ __forceinline__ float dppf(float x) { return __builtin_bit_cast(float, __builtin_amdgcn_mov_dpp(__builtin_bit_cast(int, x), CTRL, 0xf, 0xf, true)); }
__device__ __forceinline__ void swap32(float& a, float& b) { asm volatile("v_nop\n\tv_nop\n\tv_permlane32_swap_b32 %0, %1" : "+v"(a), "+v"(b)); }
__device__ __forceinline__ void swap16(float& a, float& b) { asm volatile("v_nop\n\tv_nop\n\tv_permlane16_swap_b32 %0, %1" : "+v"(a), "+v"(b)); }
__device__ __forceinline__ float swap16_sum(float x) { float a = x, b = x; swap16(a, b); return a + b; }
__device__ __forceinline__ float swap32_sum(float x) { float a = x, b = x; swap32(a, b); return a + b; }
__device__ __forceinline__ float wave_sum(float v) {
    v += dppf<0xB1>(v);
    v += dppf<0x4E>(v);
    v += dppf<0x141>(v);
    v += dppf<0x128>(v);
    v = swap16_sum(v);
    return swap32_sum(v);
}
#define LDS_WAIT() asm volatile("s_waitcnt lgkmcnt(0)" ::: "memory")

struct Params {
    const float *x, *g_pre_mix, *w_in, *conv_w, *conv_b, *ln_g, *ln_b, *attn_g, *w_out, *g_post_mix, *g_pre_ffn, *w_gate, *w_up, *w_down, *g_post_ffn;
    float* out; unsigned char* ws;
};

__device__ __forceinline__ void transpose_item(const float* W, int K, int N, bf16* WT, int drow0, LAS float* scr, int kb, int nb, int lane, const float* gk = nullptr) {
    const int k0 = 64 * kb, n0 = 32 * nb;
#pragma unroll
    for (int i = 0; i < 32; ++i) { const int kk = 2 * i + (lane >> 5); scr[kk * 33 + (lane & 31)] = __builtin_nontemporal_load(W + (size_t)(k0 + kk) * N + n0 + (lane & 31)); }
    LDS_WAIT(); asm volatile("" ::: "memory");
    const int c = lane & 7;
    f32x4 ga = (f32x4){1.f, 1.f, 1.f, 1.f}, gb = ga;
    if (gk) { ga = *(const GAS f32x4*)(gk + k0 + 8 * c); gb = *(const GAS f32x4*)(gk + k0 + 8 * c + 4); }
#pragma unroll
    for (int j = 0; j < 4; ++j) { const int n = (lane >> 3) + 8 * j; const LAS float* s = scr + (8 * c) * 33 + n;
        v4u o; o.x = cvtpk(s[0 * 33] * ga.x, s[1 * 33] * ga.y); o.y = cvtpk(s[2 * 33] * ga.z, s[3 * 33] * ga.w); o.z = cvtpk(s[4 * 33] * gb.x, s[5 * 33] * gb.y); o.w = cvtpk(s[6 * 33] * gb.z, s[7 * 33] * gb.w);
        *(GAS v4u*)(WT + (size_t)(drow0 + n) * K + k0 + 8 * c) = o; }
    LDS_WAIT(); asm volatile("" ::: "memory");
}

constexpr int WI_IN = 16 * (IN_COLS / 32), WI_ALL = WI_IN + 16 * 32 + 2 * 16 * (FF / 32) + (FF / 64) * 32;
__device__ __forceinline__ void weight_items(const Params& p, LAS float* scr, int gw, int NGW, int lane, int it_lo, int it_hi) {
    bf16* Win_t = (bf16*)(p.ws + WS_WIN); bf16* Wout_t = (bf16*)(p.ws + WS_WOUT); bf16* Wgu_t = (bf16*)(p.ws + WS_WGU); bf16* Wd_t = (bf16*)(p.ws + WS_WD);
    constexpr int I_IN = 16 * (IN_COLS / 32), I_OUT = 16 * 32, I_G = 16 * (FF / 32), I_D = (FF / 64) * 32;
    constexpr int NITEMS = I_IN + I_OUT + 2 * I_G + I_D;
    static_assert(NITEMS == WI_ALL && I_IN == WI_IN, "item counts");
    for (int it = it_lo + gw; it < it_hi; it += NGW) {
        int r = it;
        if (r < I_IN) { const int nblk = IN_COLS / 32, kb = r / nblk, nb = r % nblk, n0 = 32 * nb; int dr;
            if (n0 < 512) dr = 256 * (n0 >> 7) + (n0 & 127); else if (n0 < 1024) dr = 256 * ((n0 - 512) >> 7) + 128 + (n0 & 127); else dr = n0;
            transpose_item(p.w_in, D, IN_COLS, Win_t, dr, scr, kb, nb, lane, p.g_pre_mix); continue; } r -= I_IN;
        if (r < I_OUT) { transpose_item(p.w_out, D, D, Wout_t, 32 * (r % 32), scr, r / 32, r % 32, lane); continue; } r -= I_OUT;
        if (r < I_G) { const int nblk = FF / 32, kb = r / nblk, nb = r % nblk, n0 = 32 * nb; transpose_item(p.w_gate, D, FF, Wgu_t, 256 * (n0 >> 7) + (n0 & 127), scr, kb, nb, lane, p.g_pre_ffn); continue; } r -= I_G;
        if (r < I_G) { const int nblk = FF / 32, kb = r / nblk, nb = r % nblk, n0 = 32 * nb; transpose_item(p.w_up, D, FF, Wgu_t, 256 * (n0 >> 7) + 128 + (n0 & 127), scr, kb, nb, lane, p.g_pre_ffn); continue; } r -= I_G;
        transpose_item(p.w_down, FF, D, Wd_t, 32 * (r % 32), scr, r / 32, r % 32, lane);
    }
}
__device__ __forceinline__ void phase_prologue(const Params& p, LAS unsigned char* lds, int gw, int NGW, int wave, int lane) {
    weight_items(p, (LAS float*)(lds + wave * 16384), gw, NGW, lane, 0, WI_IN);
    bf16* XN = (bf16*)(p.ws + WS_XN); float* R0 = (float*)(p.ws + WS_R1);
    for (int m = gw; m < M; m += NGW) {
        const GAS f32x4* xr = (const GAS f32x4*)(p.x + (size_t)m * D) + lane;
        f32x4 v[4]; float s = 0.f;
#pragma unroll
        for (int j = 0; j < 4; ++j) { v[j] = __builtin_nontemporal_load(xr + 64 * j); s += (v[j].x * v[j].x + v[j].y * v[j].y) + (v[j].z * v[j].z + v[j].w * v[j].w); }
        const float rms = sqrtf(wave_sum(s) * (1.f / D) + EPS), rstd = 1.0f / rms;
        if (lane == 0) R0[m] = rms;
        GAS v2u* o8 = (GAS v2u*)(XN + (size_t)m * D) + lane;
#pragma unroll
        for (int j = 0; j < 4; ++j) { v2u o; o.x = cvtpk(v[j].x * rstd, v[j].y * rstd); o.y = cvtpk(v[j].z * rstd, v[j].w * rstd); o8[64 * j] = o; }
    }
}

constexpr int CV_T = 32, CV_IN_ROWS = CV_T + CONV_W - 1, CV_IN_BYTES = CV_IN_ROWS * CONV_CH * 2, CV_OUT_OFF = CV_IN_BYTES;
static_assert(CV_OUT_OFF + CV_T * CONV_CH * 4 <= 131072 && (CV_OUT_OFF % 16) == 0, "conv LDS map");
__device__ __forceinline__ void phase_conv(const Params& p, LAS unsigned char* lds, int bid, int G, int tid, int wave, int lane) {
    const bf16* GLU = (const bf16*)(p.ws + WS_GLU); bf16* MIX = (bf16*)(p.ws + WS_MIX);
    const int cp = tid & 255, half = tid >> 8;
    float cw0[CONV_W], cw1[CONV_W];
#pragma unroll
    for (int w = 0; w < CONV_W; ++w) { cw0[w] = p.conv_w[w * CONV_CH + 2 * cp]; cw1[w] = p.conv_w[w * CONV_CH + 2 * cp + 1]; }
    const float cb0 = p.conv_b[2 * cp], cb1 = p.conv_b[2 * cp + 1];
    LAS float* outp = (LAS float*)(lds + CV_OUT_OFF);
#define CV_LOAD(SV, TILE) do { const int tok0_ = (TILE) * CV_T, tin_ = tok0_ % SEQ; \
        _Pragma("unroll") for (int i = 0; i < 8; ++i) { const int ch = tid + i * (NWAVES * 64), rr = ch >> 6, c16 = ch & 63, t = tin_ - (CONV_W - 1) + rr; \
            SV[i] = (v4u){0u, 0u, 0u, 0u}; \
            if (ch < CV_IN_ROWS * 64 && t >= 0) SV[i] = *(const GAS v4u*)(GLU + (size_t)(tok0_ - (CONV_W - 1) + rr) * CONV_CH + c16 * 8); } } while (0)
    v4u sv[8];
    if (bid < M / CV_T) CV_LOAD(sv, bid);
    for (int tile = bid; tile < M / CV_T; tile += G) {
        const int tok0 = tile * CV_T;
#pragma unroll
        for (int i = 0; i < 8; ++i) { const int ch = tid + i * (NWAVES * 64), rr = ch >> 6, c16 = ch & 63;
            if (ch < CV_IN_ROWS * 64) *(LAS v4u*)(lds + rr * 1024 + c16 * 16) = sv[i]; }
        if (tile + G < M / CV_T) CV_LOAD(sv, tile + G);
        __syncthreads();
#pragma unroll
        for (int ob = 0; ob < 2; ++ob) {
            const int o0 = 16 * half + 8 * ob;
            float a0[8], a1[8];
#pragma unroll
            for (int o = 0; o < 8; ++o) { a0[o] = cb0; a1[o] = cb1; }
#pragma unroll
            for (int j = 0; j < 8 + CONV_W - 1; ++j) {
                const unsigned u = *(const LAS unsigned*)(lds + (o0 + j) * 1024 + cp * 4);
                const float v0 = bf_lo(u), v1 = bf_hi(u);
#pragma unroll
                for (int o = 0; o < 8; ++o) { const int w = j - o; if (w >= 0 && w < CONV_W) { a0[o] += v0 * cw0[w]; a1[o] += v1 * cw1[w]; } }
                if ((j & 3) == 3) __builtin_amdgcn_sched_barrier(0);
            }
#pragma unroll
            for (int o = 0; o < 8; ++o) *(LAS f32x2_t*)(outp + (o0 + o) * CONV_CH + 2 * cp) = (f32x2_t){a0[o], a1[o]};
        }
        __syncthreads();
        { f32x4 lg[2], lb[2];
#pragma unroll
          for (int j = 0; j < 2; ++j) { lg[j] = *((const GAS f32x4*)p.ln_g + 2 * lane + j); lb[j] = *((const GAS f32x4*)p.ln_b + 2 * lane + j); }
          f32x4 v0[4], v1[4]; float sm[4], sq[4];
#pragma unroll
          for (int q = 0; q < 4; ++q) { const int tk = wave + 8 * q;
              v0[q] = *(const LAS f32x4*)(outp + tk * CONV_CH + 8 * lane); v1[q] = *(const LAS f32x4*)(outp + tk * CONV_CH + 8 * lane + 4);
              sm[q] = (v0[q].x + v0[q].y) + (v0[q].z + v0[q].w) + (v1[q].x + v1[q].y) + (v1[q].z + v1[q].w); }
#pragma unroll
          for (int q = 0; q < 4; ++q) sm[q] = wave_sum(sm[q]);
#pragma unroll
          for (int q = 0; q < 4; ++q) { const float mu = sm[q] * (1.f / CONV_CH); v0[q] = v0[q] - mu; v1[q] = v1[q] - mu;
              sq[q] = (v0[q].x * v0[q].x + v0[q].y * v0[q].y) + (v0[q].z * v0[q].z + v0[q].w * v0[q].w) + (v1[q].x * v1[q].x + v1[q].y * v1[q].y) + (v1[q].z * v1[q].z + v1[q].w * v1[q].w); }
#pragma unroll
          for (int q = 0; q < 4; ++q) sq[q] = wave_sum(sq[q]);
#pragma unroll
          for (int q = 0; q < 4; ++q) { const int tk = wave + 8 * q;
              const float rstd = 1.0f / sqrtf(sq[q] * (1.f / CONV_CH) + EPS);
              f32x4 y0 = v0[q] * rstd * lg[0] + lb[0], y1 = v1[q] * rstd * lg[1] + lb[1];
#pragma unroll
              for (int i = 0; i < 4; ++i) { y0[i] = y0[i] * pg8::sigm(y0[i]); y1[i] = y1[i] * pg8::sigm(y1[i]); }
              v4u o; o.x = cvtpk(y0.x, y0.y); o.y = cvtpk(y0.z, y0.w); o.z = cvtpk(y1.x, y1.y); o.w = cvtpk(y1.z, y1.w);
              *(GAS v4u*)(MIX + (size_t)(tok0 + tk) * D + 8 * lane) = o; } }
        __syncthreads();
    }
}

#define MFMA32(a, b, c) __builtin_amdgcn_mfma_f32_32x32x16_bf16((a), (b), (c), 0, 0, 0)
constexpr int AT_KP = 144, AT_VP = 80, AT_KB = 32 * AT_KP, AT_WB = AT_KB + 64 * AT_VP;
static_assert(8 * AT_WB <= 131072 && (AT_WB % 16) == 0, "attention LDS map");
__device__ __forceinline__ void attn_unit(const bf16* QK, const bf16* VT, bf16* MIX, const float* attn_g, int b, int h, int qt, int lane, LAS unsigned char* wl) {
    const int r = lane & 31, hf = lane >> 5;
    const size_t tok0 = (size_t)b * SEQ + (size_t)qt * 32;
    bf16x8 qf[4];
    { const bf16* qp = QK + (tok0 + r) * 1024 + h * 64 + 8 * hf;
#pragma unroll
      for (int s = 0; s < 4; ++s) qf[s] = *(const GAS bf16x8*)(qp + 16 * s); }
    f32x16 o0, o1;
#pragma unroll
    for (int i = 0; i < 16; ++i) { o0[i] = 0.f; o1[i] = 0.f; }
    float carry = 0.f;
    constexpr float ZS = 0.125f * LOG2E;
    const bf16* kg = QK + ((size_t)b * SEQ + (lane >> 3)) * 1024 + 512 + h * 64 + (lane & 7) * 8;
    const bf16* vg = VT + (size_t)(h * 64 + (lane >> 2)) * M + (size_t)b * SEQ + (lane & 3) * 8;
    LAS unsigned char* kw = wl + (lane >> 3) * AT_KP + (lane & 7) * 16;
    LAS unsigned char* vw = wl + AT_KB + (lane >> 2) * AT_VP + (lane & 3) * 16;
    const int pr = (r & 0x13) | ((r & 4) << 1) | ((r & 8) >> 1);
    const LAS unsigned char* kr = wl + pr * AT_KP + 16 * hf;
    const LAS unsigned char* vr = wl + AT_KB + r * AT_VP + 16 * hf;
#define ATT_LOAD(SK, SV, KB) do { _Pragma("unroll") for (int i = 0; i < 4; ++i) { \
        SK[i] = *(const GAS v4u*)(kg + (size_t)((KB) + 8 * i) * 1024); SV[i] = *(const GAS v4u*)(vg + (size_t)(16 * i) * M + (KB)); } } while (0)
    v4u sk[4], sv[4];
    ATT_LOAD(sk, sv, qt * 32);
    for (int kb = qt * 32; kb >= 0; kb -= 32) {
#pragma unroll
        for (int i = 0; i < 4; ++i) { *(LAS v4u*)(kw + 8 * i * AT_KP) = sk[i]; *(LAS v4u*)(vw + 16 * i * AT_VP) = sv[i]; }
        if (kb >= 32) ATT_LOAD(sk, sv, kb - 32);
        bf16x8 kf[4], vf[2][2];
#pragma unroll
        for (int s = 0; s < 4; ++s) kf[s] = *(const LAS bf16x8*)(kr + 32 * s);
#pragma unroll
        for (int db = 0; db < 2; ++db)
#pragma unroll
            for (int s = 0; s < 2; ++s) vf[db][s] = *(const LAS bf16x8*)(vr + db * 32 * AT_VP + 32 * s);
        f32x16 st;
#pragma unroll
        for (int i = 0; i < 16; ++i) st[i] = 0.f;
#pragma unroll
        for (int s = 0; s < 4; ++s) st = MFMA32(kf[s], qf[s], st);
        const bool diag = (kb == qt * 32);
        float lbv[16], l1[16];
#pragma unroll
        for (int i = 0; i < 16; ++i) {
            const float z = st[i] * ZS;
            const float L = __builtin_amdgcn_logf(1.0f + __builtin_amdgcn_exp2f(-fabsf(z)));
            lbv[i] = fminf(z, 0.f) - L;
            l1[i] = fminf(-z, 0.f) - L;
            if (diag) { const int key = 16 * (i >> 3) + 8 * hf + (i & 7); if (key >= r) { l1[i] = 0.f; lbv[i] = -1e30f; } }
        }
        float e[16], tot[2], pt[2];
#pragma unroll
        for (int a = 0; a < 2; ++a) { e[8 * a + 7] = 0.f;
#pragma unroll
            for (int j = 6; j >= 0; --j) e[8 * a + j] = e[8 * a + j + 1] + l1[8 * a + j + 1];
            tot[a] = e[8 * a] + l1[8 * a]; }
#pragma unroll
        for (int a = 0; a < 2; ++a) { float lo_ = tot[a], hi_ = tot[a]; swap32(lo_, hi_); tot[a] = lo_; pt[a] = hi_; }
        const float pair1 = tot[1] + pt[1], btot = (tot[0] + pt[0]) + pair1;
        float off[2];
        off[1] = carry + (hf == 0 ? pt[1] : 0.f); off[0] = carry + pair1 + (hf == 0 ? pt[0] : 0.f);
        float pv[16];
#pragma unroll
        for (int i = 0; i < 16; ++i) pv[i] = __builtin_amdgcn_exp2f(lbv[i] + (off[i >> 3] + e[i]));
        bf16x8 pk[2];
#pragma unroll
        for (int s = 0; s < 2; ++s) { v4u w; w.x = cvtpk(pv[8 * s], pv[8 * s + 1]); w.y = cvtpk(pv[8 * s + 2], pv[8 * s + 3]); w.z = cvtpk(pv[8 * s + 4], pv[8 * s + 5]); w.w = cvtpk(pv[8 * s + 6], pv[8 * s + 7]); pk[s] = __builtin_bit_cast(bf16x8, w); }
        o0 = MFMA32(vf[0][0], pk[0], o0); o0 = MFMA32(vf[0][1], pk[1], o0);
        o1 = MFMA32(vf[1][0], pk[0], o1); o1 = MFMA32(vf[1][1], pk[1], o1);
        carry += btot;
        if (__all(carry < -160.f)) break;
    }
#undef ATT_LOAD
    float ss = 0.f;
#pragma unroll
    for (int i = 0; i < 16; ++i) ss += o0[i] * o0[i] + o1[i] * o1[i];
    ss = swap32_sum(ss);
    const float rstd = 1.0f / sqrtf(ss * (1.f / HD) + EPS);
    bf16* op = MIX + (tok0 + r) * D + 512 + h * 64 + 4 * hf;
    const float* gp = attn_g + h * 64 + 4 * hf;
#pragma unroll
    for (int g = 0; g < 4; ++g) {
        const f32x4 g0 = *(const GAS f32x4*)(gp + 8 * g), g1 = *(const GAS f32x4*)(gp + 32 + 8 * g);
        v2u w0, w1;
        w0.x = cvtpk(o0[4 * g] * rstd * g0.x, o0[4 * g + 1] * rstd * g0.y); w0.y = cvtpk(o0[4 * g + 2] * rstd * g0.z, o0[4 * g + 3] * rstd * g0.w);
        w1.x = cvtpk(o1[4 * g] * rstd * g1.x, o1[4 * g + 1] * rstd * g1.y); w1.y = cvtpk(o1[4 * g + 2] * rstd * g1.z, o1[4 * g + 3] * rstd * g1.w);
        *(GAS v2u*)(op + 8 * g) = w0; *(GAS v2u*)(op + 32 + 8 * g) = w1;
    }
}
__device__ __forceinline__ void phase_attn(const Params& p, int gw, int NGW, int lane, LAS unsigned char* wl) {
    const bf16* QK = (const bf16*)(p.ws + WS_QK); const bf16* VT = (const bf16*)(p.ws + WS_VT); bf16* MIX = (bf16*)(p.ws + WS_MIX);
    constexpr int NQT = SEQ / 32, NUNITS = BATCH * NH * NQT;
    for (int u = gw; u < NUNITS; u += NGW) { const int qt = u % NQT, h = (u / NQT) % NH, b = u / (NQT * NH); attn_unit(QK, VT, MIX, p.attn_g, b, h, qt, lane, wl); }
}

__device__ __forceinline__ f32x4 ld_bf4(const bf16* row, int lane, int j) { const v2u u = *((const GAS v2u*)row + lane + 64 * j); return (f32x4){bf_lo(u.x), bf_hi(u.x), bf_lo(u.y), bf_hi(u.y)}; }
__device__ __forceinline__ f32x4 ld_bf4_nt(const bf16* row, int lane, int j) { const v2u u = __builtin_nontemporal_load((const GAS v2u*)row + lane + 64 * j); return (f32x4){bf_lo(u.x), bf_hi(u.x), bf_lo(u.y), bf_hi(u.y)}; }
__device__ __forceinline__ float ssq4(const f32x4 v) { return (v.x * v.x + v.y * v.y) + (v.z * v.z + v.w * v.w); }
__device__ __forceinline__ void phase_mid_rows(const Params& p, int gw, int NGW, int lane) {
    const bf16* YB = (const bf16*)(p.ws + WS_Y); bf16* XN = (bf16*)(p.ws + WS_XN); float* R0 = (float*)(p.ws + WS_R1);
    f32x4 g1[4];
#pragma unroll
    for (int j = 0; j < 4; ++j) g1[j] = *((const GAS f32x4*)p.g_post_mix + lane + 64 * j);
    constexpr int RB = 2;
    for (int m0 = gw; m0 < M; m0 += RB * NGW) {
        f32x4 y[RB][4], x[RB][4]; float s[RB], s2[RB], rx[RB];
#pragma unroll
        for (int q = 0; q < RB; ++q) { const int m = (m0 + q * NGW < M) ? m0 + q * NGW : m0; rx[q] = R0[m]; s[q] = 0.f;
#pragma unroll
            for (int j = 0; j < 4; ++j) { y[q][j] = ld_bf4_nt(YB + (size_t)m * D, lane, j); x[q][j] = ld_bf4(XN + (size_t)m * D, lane, j); s[q] += ssq4(y[q][j]); } }
#pragma unroll
        for (int q = 0; q < RB; ++q) s[q] = wave_sum(s[q]);
#pragma unroll
        for (int q = 0; q < RB; ++q) { const float r1 = 1.0f / sqrtf(s[q] * (1.f / D) + EPS); s2[q] = 0.f;
#pragma unroll
            for (int j = 0; j < 4; ++j) { x[q][j] = x[q][j] * rx[q] + y[q][j] * r1 * g1[j]; s2[q] += ssq4(x[q][j]); } }
#pragma unroll
        for (int q = 0; q < RB; ++q) s2[q] = wave_sum(s2[q]);
#pragma unroll
        for (int q = 0; q < RB; ++q) { const int m = m0 + q * NGW; if (m < M) {
            const float rms2 = sqrtf(s2[q] * (1.f / D) + EPS), r2 = 1.0f / rms2;
            if (lane == 0) R0[m] = rms2;
            GAS v2u* o8 = (GAS v2u*)(XN + (size_t)m * D) + lane;
#pragma unroll
            for (int j = 0; j < 4; ++j) { const f32x4 f = x[q][j] * r2; v2u o; o.x = cvtpk(f.x, f.y); o.y = cvtpk(f.z, f.w); o8[64 * j] = o; } } }
    }
}
__device__ __forceinline__ void phase_final_rows(const Params& p, int gw, int NGW, int lane) {
    const bf16* XN = (const bf16*)(p.ws + WS_XN); const bf16* FB = (const bf16*)(p.ws + WS_Y + 64 * MiB); const float* R0 = (const float*)(p.ws + WS_R1);
    f32x4 g3[4];
#pragma unroll
    for (int j = 0; j < 4; ++j) g3[j] = *((const GAS f32x4*)p.g_post_ffn + lane + 64 * j);
    constexpr int RB = 2;
    for (int m0 = gw; m0 < M; m0 += RB * NGW) {
        f32x4 f[RB][4], h[RB][4]; float sf[RB], rh[RB];
#pragma unroll
        for (int q = 0; q < RB; ++q) { const int m = (m0 + q * NGW < M) ? m0 + q * NGW : m0; rh[q] = R0[m]; sf[q] = 0.f;
#pragma unroll
            for (int j = 0; j < 4; ++j) { f[q][j] = ld_bf4_nt(FB + (size_t)m * D, lane, j); h[q][j] = ld_bf4_nt(XN + (size_t)m * D, lane, j); sf[q] += ssq4(f[q][j]); } }
#pragma unroll
        for (int q = 0; q < RB; ++q) sf[q] = wave_sum(sf[q]);
#pragma unroll
        for (int q = 0; q < RB; ++q) { const int m = m0 + q * NGW; if (m < M) {
            const float r3 = 1.0f / sqrtf(sf[q] * (1.f / D) + EPS);
            GAS f32x4* orow = (GAS f32x4*)(p.out + (size_t)m * D) + lane;
#pragma unroll
            for (int j = 0; j < 4; ++j) __builtin_nontemporal_store(h[q][j] * rh[q] + f[q][j] * r3 * g3[j], orow + 64 * j); } }
    }
}

#define RLX_AGENT __ATOMIC_RELAXED, __HIP_MEMORY_SCOPE_AGENT
#define XB_TMO      128
#define XB_XCNT(j)  (256  + 64 * (j))
#define XB_XSUB(j)  (1280 + 64 * (j))
#define XB_XGEN(j)  (2304 + 64 * (j))
#define XB_TOP      3328
#define XB_TOPGEN   3392
#define XCD_BAR_WORDS 3456
#define XB_SPIN_CAP (1u << 18)

__device__ __forceinline__ unsigned xb_ld(unsigned* p)              { return __hip_atomic_load(p, __ATOMIC_RELAXED, __HIP_MEMORY_SCOPE_AGENT); }
__device__ __forceinline__ unsigned xb_add(unsigned* p, unsigned v) { return __hip_atomic_fetch_add(p, v, __ATOMIC_RELAXED, __HIP_MEMORY_SCOPE_AGENT); }
__device__ __forceinline__ unsigned xb_xcc_id() { return (unsigned)__builtin_amdgcn_s_getreg((3 << 11) | 20) & 0xFu; }
#define XB_SPIN(cond, bar) do { unsigned _sp = 0; while (cond) { __builtin_amdgcn_s_sleep(1); \
    if ((++_sp & 255u) == 0u) { if (xb_ld(&(bar)[XB_TMO])) break; if (_sp > XB_SPIN_CAP) { atomicAdd(&(bar)[XB_TMO], 1u); break; } } } } while (0)

struct XcdBarrier {
    unsigned* bar; unsigned x;
    volatile LAS unsigned* st;
};

__device__ __forceinline__ XcdBarrier xcd_barrier_post(unsigned* bar, volatile LAS unsigned* st) {
    XcdBarrier b; b.bar = bar; b.x = xb_xcc_id(); b.st = st;
    if (threadIdx.x == 0) (void)xb_add(&bar[XB_XCNT(b.x)], 1u);
    return b;
}
__device__ __forceinline__ void xcd_barrier_complete(unsigned* bar, unsigned x, unsigned& nloc, unsigned& nx) {
    const unsigned G = gridDim.x * gridDim.y * gridDim.z;
    unsigned sum, cnt, mine, sp = 0u;
    for (;;) {
        sum = 0u; cnt = 0u; mine = 0u;
#pragma unroll
        for (unsigned j = 0; j < 16; ++j) { const unsigned c = xb_ld(&bar[XB_XCNT(j)]); sum += c; cnt += (c > 0u) ? 1u : 0u; mine = (j == x) ? c : mine; }
        if (sum == G) break;
        __builtin_amdgcn_s_sleep(1);
        if ((++sp & 255u) == 0u) { if (xb_ld(&bar[XB_TMO])) break; if (sp > XB_SPIN_CAP) { atomicAdd(&bar[XB_TMO], 1u); break; } }
    }
    nloc = mine > 0u ? mine : 1u; nx = cnt > 0u ? cnt : 1u;
}

__device__ __forceinline__ void xcd_barrier(const XcdBarrier& b) {
    asm volatile("s_waitcnt vmcnt(0)" ::: "memory");
    __syncthreads();
    if (threadIdx.x == 0) {
        unsigned* bar = b.bar;
        __builtin_amdgcn_s_waitcnt(0);
        unsigned nloc = b.st[0], nx = b.st[1];
        if (nloc == 0u) { xcd_barrier_complete(bar, b.x, nloc, nx); b.st[0] = nloc; b.st[1] = nx; }
        const unsigned old = xb_add(&bar[XB_XSUB(b.x)], 1u);
        const unsigned gen = old / nloc;
        if (old + 1u == (gen + 1u) * nloc) {
            __builtin_amdgcn_fence(__ATOMIC_RELEASE, "agent");
            asm volatile("s_waitcnt vmcnt(0)" ::: "memory");
            const unsigned og = xb_add(&bar[XB_TOP], 1u);
            const unsigned tg = og / nx;
            if (og + 1u == (tg + 1u) * nx) xb_add(&bar[XB_TOPGEN], 1u);
            else XB_SPIN(xb_ld(&bar[XB_TOPGEN]) == tg, bar);
            __builtin_amdgcn_fence(__ATOMIC_ACQUIRE, "agent");
            xb_add(&bar[XB_XGEN(b.x)], 1u);
            asm volatile("s_waitcnt vmcnt(0)" ::: "memory");
        } else {
            XB_SPIN(xb_ld(&bar[XB_XGEN(b.x)]) == gen, bar);
            __builtin_amdgcn_fence(__ATOMIC_ACQUIRE, "agent");
            asm volatile("s_waitcnt vmcnt(0)" ::: "memory");
        }
    }
    __syncthreads();
}

__global__ void __launch_bounds__(NWAVES * 64, 2) fwd_megakernel(Params p) {
    extern __shared__ __attribute__((aligned(16))) unsigned char lds_raw[];
    cg::grid_group grid = cg::this_grid();
    LAS unsigned char* lds = (LAS unsigned char*)lds_raw;
    const int tid = threadIdx.x, lane = tid & 63, wave = __builtin_amdgcn_readfirstlane(tid >> 6);
    const int G = gridDim.x, bid = blockIdx.x, gw = bid * NWAVES + wave, NGW = G * NWAVES;
    bf16* Win_t = (bf16*)(p.ws + WS_WIN); bf16* Wout_t = (bf16*)(p.ws + WS_WOUT); bf16* Wgu_t = (bf16*)(p.ws + WS_WGU); bf16* Wd_t = (bf16*)(p.ws + WS_WD);
    bf16* XN = (bf16*)(p.ws + WS_XN); float* Y = (float*)(p.ws + WS_Y); bf16* GLU = (bf16*)(p.ws + WS_GLU); bf16* QK = (bf16*)(p.ws + WS_QK);
    bf16* VT = (bf16*)(p.ws + WS_VT); bf16* MIX = (bf16*)(p.ws + WS_MIX); bf16* ACT = (bf16*)(p.ws + WS_ACT);

    volatile LAS unsigned* MISC = (volatile LAS unsigned*)(lds + 131072 + 320);
    if (tid < 32) MISC[tid] = 0u;
    __syncthreads();
    XcdBarrier bar = xcd_barrier_post((unsigned*)(p.ws + WS_CTL), MISC + 8);
    if (p.out == nullptr) grid.sync();
#define GRID_BAR() xcd_barrier(bar)
    phase_prologue(p, lds, gw, NGW, wave, lane);
    GRID_BAR();
    { static_assert(WS_WIN + (size_t)2048 * D * 2 + 40 * (size_t)(256 * D * 2) == WS_XN && WS_WIN + 48 * (size_t)(256 * D * 2) == WS_XN, "OrderIn tile shifts");
      pg8::Gemm g{XN, Win_t, M, IN_COLS, D}; pg8::OrderIn S{G, bid}; pg8::EpiIn E{GLU, QK, VT, M};
      pg8::gemm_phase<pg8::EpiIn, pg8::OrderIn, true, true>(lds, g, S, E); }
    GRID_BAR();
    phase_conv(p, lds, bid, G, tid, wave, lane);
    phase_attn(p, gw, NGW, lane, lds + wave * AT_WB);
    weight_items(p, (LAS float*)(lds + wave * AT_WB), gw, NGW, lane, WI_IN, WI_ALL);
    GRID_BAR();
    { pg8::Gemm g{MIX, Wout_t, M, D, D}; pg8::StaticOrder S; S.init(M, D, G, bid); pg8::EpiBf16<0> E{(bf16*)Y, D, nullptr, 0, 0, 1.f};
      pg8::gemm_phase<pg8::EpiBf16<0>, pg8::StaticOrder, true, true>(lds, g, S, E); }
    GRID_BAR();
    phase_mid_rows(p, gw, NGW, lane);
    GRID_BAR();
    { pg8::Gemm g{XN, Wgu_t, M, 2 * FF, D}; pg8::StaticOrder S; S.init(M, 2 * FF, G, bid); pg8::EpiGate<1> E{ACT, FF};
      pg8::gemm_phase<pg8::EpiGate<1>, pg8::StaticOrder, true, true>(lds, g, S, E); }
    GRID_BAR();
    { pg8::Gemm g{ACT, Wd_t, M, D, FF}; pg8::StaticOrder S; S.init(M, D, G, bid); pg8::EpiBf16<0> E{(bf16*)Y + (size_t)M * D, D, nullptr, 0, 0, 1.f};
      pg8::gemm_phase<pg8::EpiBf16<0>, pg8::StaticOrder, true, true>(lds, g, S, E); }
    GRID_BAR();
    phase_final_rows(p, gw, NGW, lane);
}

extern "C" void kernel_launch(void* const* d_in, const int* in_sizes, int n_in, void* d_out, int out_size, void* d_ws, size_t ws_size, hipStream_t stream) {
    static int grid = 0;
    if (grid == 0) {
        if (n_in != 15 || in_sizes[0] != M * D || out_size != M * D || ws_size < WS_END) { fprintf(stderr, "kernel_launch: unexpected shapes (n_in %d, in0 %d, out %d, ws %zu)\n", n_in, n_in > 0 ? in_sizes[0] : -1, out_size, ws_size); grid = -1; return; }
        int dev = 0, cus = 0, per_cu = 0;
        hipGetDevice(&dev); hipDeviceGetAttribute(&cus, hipDeviceAttributeMultiprocessorCount, dev);
        if (hipFuncSetAttribute((const void*)fwd_megakernel, hipFuncAttributeMaxDynamicSharedMemorySize, LDS_BYTES) != hipSuccess) { fprintf(stderr, "kernel_launch: hipFuncSetAttribute failed\n"); grid = -1; return; }
        if (hipOccupancyMaxActiveBlocksPerMultiprocessor(&per_cu, (const void*)fwd_megakernel, NWAVES * 64, LDS_BYTES) != hipSuccess || per_cu < 1) { fprintf(stderr, "kernel_launch: occupancy query says %d\n", per_cu); per_cu = 1; }
        (void)hipGetLastError();
        grid = cus;
    }
    if (grid < 0) return;
    if (hipMemsetAsync((char*)d_ws + WS_CTL, 0, CTL_BYTES, stream) != hipSuccess) { fprintf(stderr, "kernel_launch: memset failed\n"); return; }
    Params p{};
    p.x = (const float*)d_in[0]; p.g_pre_mix = (const float*)d_in[1]; p.w_in = (const float*)d_in[2]; p.conv_w = (const float*)d_in[3]; p.conv_b = (const float*)d_in[4];
    p.ln_g = (const float*)d_in[5]; p.ln_b = (const float*)d_in[6]; p.attn_g = (const float*)d_in[7]; p.w_out = (const float*)d_in[8]; p.g_post_mix = (const float*)d_in[9];
    p.g_pre_ffn = (const float*)d_in[10]; p.w_gate = (const float*)d_in[11]; p.w_up = (const float*)d_in[12]; p.w_down = (const float*)d_in[13]; p.g_post_ffn = (const float*)d_in[14];
    p.out = (float*)d_out; p.ws = (unsigned char*)d_ws;
    void* args[] = {&p};
    hipError_t e = hipLaunchCooperativeKernel((const void*)fwd_megakernel, dim3(grid), dim3(NWAVES * 64), args, LDS_BYTES, stream);
    if (e != hipSuccess) fprintf(stderr, "kernel_launch: cooperative launch failed: %s (grid %d)\n", hipGetErrorString(e), grid);
}
```

```cpp
#include <hip/hip_runtime.h>
#include <hip/hip_cooperative_groups.h>
#include <cstdio>
#include <cstdint>
namespace cg = cooperative_groups;
namespace pg8 {
#define PG8_LAS __attribute__((address_space(3)))
typedef unsigned short bf16_t;
typedef short bf16x8 __attribute__((ext_vector_type(8)));
typedef float f32x4 __attribute__((ext_vector_type(4)));
typedef unsigned u32x4 __attribute__((ext_vector_type(4)));
constexpr int BM = 256, BK = 64, HALF = 128, HTB = HALF * BK * 2  , STAGE_BYTES = 8 * HTB, NXCD = 8, WGM = 8;

__host__ __device__ __forceinline__ int lds_byte(int r, int c) { const int st = (r >> 4) * 2 + (c >> 5), rr = r & 15, cc = c & 31, ob = rr * 64 + cc * 2; return st * 1024 + (ob ^ (((ob >> 9) & 1) << 5)); }
__host__ __device__ __forceinline__ void stage_rc(int b, int& R, int& C) { const int st = b / 1024, sb = b % 1024, swz = sb ^ (((sb >> 9) & 1) << 5); R = (st >> 1) * 16 + swz / 64; C = (st & 1) * 32 + (swz % 64) / 2; }
__host__ __device__ __forceinline__ int perm32(int rho) { const int n = rho >> 4, i = rho & 15; return 8 * (i >> 2) + 4 * n + (i & 3); }

struct Unit { int pm, pn; };
struct Gemm { const bf16_t* A; const bf16_t* Bt; int M, N, K; };

struct StaticOrder {
    int nM, nN, nwg, G, c;
    __host__ __device__ void init(int M, int N, int G_, int c_) { nM = M / BM; nN = N / BM; nwg = nM * nN; G = G_; c = c_; }
    __host__ __device__ bool next(int i, Unit& u) const {
        const long L = (long)i * G + c; if (L >= nwg) return false;
        int wgid = (int)L; { const int q = nwg / NXCD, r = nwg % NXCD, xcd = wgid % NXCD, off = wgid / NXCD; wgid = (xcd < r ? xcd * (q + 1) : r * (q + 1) + (xcd - r) * q) + off; }
        const int nig = WGM * nN, gid = wgid / nig, fm = gid * WGM, gsz = (nM - fm) < WGM ? (nM - fm) : WGM;
        u.pm = fm + ((wgid % nig) % gsz); u.pn = (wgid % nig) / gsz; return true;
    }
    __device__ __forceinline__ void a_ready(const Unit&) const {}
    __device__ __forceinline__ void done(const Unit&) const {}
};

struct EpiInShift { static constexpr int VT_PM = 40, VT_PN = 48; };
struct OrderIn {
    int G, c;
    static constexpr int NA = 128 * 8, NB = 2 * 128;
    __host__ __device__ static void map_tile(int L, int nM, int nN, Unit& u) {
        const int nwg = nM * nN; int wgid = L; { const int q = nwg / NXCD, r = nwg % NXCD, xcd = wgid % NXCD, off = wgid / NXCD; wgid = (xcd < r ? xcd * (q + 1) : r * (q + 1) + (xcd - r) * q) + off; }
        const int nig = WGM * nN, gid = wgid / nig, fm = gid * WGM, gsz = (nM - fm) < WGM ? (nM - fm) : WGM;
        u.pm = fm + ((wgid % nig) % gsz); u.pn = (wgid % nig) / gsz;
    }
    __host__ __device__ bool next(int i, Unit& u) const {
        const long L = (long)i * G + c;
        if (L < NA) { map_tile((int)L, 128, 8, u); return true; }
        if (L < NA + NB) { map_tile((int)L - NA, 2, 128, u); u.pm -= EpiInShift::VT_PM; u.pn += EpiInShift::VT_PN; return true; }
        return false;
    }
    __device__ __forceinline__ void a_ready(const Unit&) const {}
    __device__ __forceinline__ void done(const Unit&) const {}
};

__device__ __forceinline__ unsigned cvt_pk_bf16(float lo, float hi) { unsigned r; asm volatile("v_cvt_pk_bf16_f32 %0, %1, %2" : "=v"(r) : "v"(lo), "v"(hi)); return r; }
typedef float f32x2 __attribute__((ext_vector_type(2)));
__device__ __forceinline__ f32x2 gelu_pk(f32x2 v) {
    const f32x2 av = __builtin_elementwise_abs(v), d = av * 0.2316418882f + 1.0f;
    f32x2 t; t.x = __builtin_amdgcn_rcpf(d.x); t.y = __builtin_amdgcn_rcpf(d.y);
    f32x2 q = t * 0.5307027145f + (-0.7265760135f); q = q * t + 0.7107068705f; q = q * t + (-0.142248368f); q = q * t + 0.127414796f; q = q * t;
    const f32x2 s = (v * v) * (-0.72134752044f);
    f32x2 e; e.x = __builtin_amdgcn_exp2f(s.x); e.y = __builtin_amdgcn_exp2f(s.y);
    const f32x2 m = v * (q * e), r = v - m;
    f32x2 o; o.x = v.x < 0.f ? m.x : r.x; o.y = v.y < 0.f ? m.y : r.y; return o;
}

template <int ACT  > struct EpiBf16 {
    static constexpr bool PERM = true, AFTER_DRAIN = false; static_assert(ACT == 0 || ACT == 1, "EpiBf16: ACT is 0 (none) or 1 (gelu_pk)");
    bf16_t* O; int ldc; const float* bias; int split_cols; size_t split_stride; float scale0;
    __device__ __forceinline__ void operator()(const f32x4 (&acc)[2][2][4][2], const Unit& u, int wr, int wc, int fr, int fq) const {
        const int row0 = u.pm * BM + wr * 64 + fr; int colt = u.pn * BM; bf16_t* base = O;
        float sc = 1.f; if (split_cols) { const int t = colt / split_cols; base += (size_t)t * split_stride; colt -= t * split_cols; if (t == 0) sc = scale0; }
        const int col0 = colt + wc * 32 + 8 * fq, bcol0 = u.pn * BM + wc * 32 + 8 * fq;
        f32x4 bv[2][2];
#pragma unroll
        for (int bj = 0; bj < 2; ++bj)
#pragma unroll
            for (int n = 0; n < 2; ++n) bv[bj][n] = bias ? *(const f32x4*)(bias + bcol0 + bj * HALF + 4 * n) : (f32x4){0.f, 0.f, 0.f, 0.f};
#pragma unroll
        for (int ai = 0; ai < 2; ++ai)
#pragma unroll
            for (int m = 0; m < 4; ++m) { bf16_t* rowp = base + (size_t)(row0 + ai * HALF + m * 16) * ldc + col0;
#pragma unroll
                for (int bj = 0; bj < 2; ++bj) { f32x4 v0 = acc[ai][bj][m][0] + bv[bj][0], v1 = acc[ai][bj][m][1] + bv[bj][1];
                    if (ACT == 1) { f32x2 a = gelu_pk((f32x2){v0[0], v0[1]}), b = gelu_pk((f32x2){v0[2], v0[3]}), c = gelu_pk((f32x2){v1[0], v1[1]}), d = gelu_pk((f32x2){v1[2], v1[3]});
                        v0 = (f32x4){a.x, a.y, b.x, b.y}; v1 = (f32x4){c.x, c.y, d.x, d.y}; }
                    v0 = v0 * sc; v1 = v1 * sc; u32x4 w; w.x = cvt_pk_bf16(v0[0], v0[1]); w.y = cvt_pk_bf16(v0[2], v0[3]); w.z = cvt_pk_bf16(v1[0], v1[1]); w.w = cvt_pk_bf16(v1[2], v1[3]);
                    *(u32x4*)(rowp + bj * HALF) = w; } }
    }
};

__device__ __forceinline__ float sigm(float x) { return __builtin_amdgcn_rcpf(1.0f + __builtin_amdgcn_exp2f(-1.4426950408889634f * x)); }
template <int MODE> struct EpiGate {
    static constexpr bool PERM = true, AFTER_DRAIN = false;
    bf16_t* O; int ldc;
    __device__ __forceinline__ void store(const f32x4 (&acc)[2][2][4][2], const Unit& u, int wr, int wc, int fr, int fq) const {
        const int row0 = u.pm * BM + wr * 64 + fr, col0 = u.pn * HALF + wc * 32 + 8 * fq;
#pragma unroll
        for (int ai = 0; ai < 2; ++ai)
#pragma unroll
            for (int m = 0; m < 4; ++m) { bf16_t* rowp = O + (size_t)(row0 + ai * HALF + m * 16) * ldc + col0;
                f32x4 r0, r1;
#pragma unroll
                for (int i = 0; i < 4; ++i) {
                    const float a00 = acc[ai][0][m][0][i], a01 = acc[ai][0][m][1][i], a10 = acc[ai][1][m][0][i], a11 = acc[ai][1][m][1][i];
                    if (MODE == 0) { r0[i] = a00 * sigm(a10); r1[i] = a01 * sigm(a11); }
                    else           { r0[i] = a00 * sigm(a00) * a10; r1[i] = a01 * sigm(a01) * a11; } }
                u32x4 w; w.x = cvt_pk_bf16(r0[0], r0[1]); w.y = cvt_pk_bf16(r0[2], r0[3]); w.z = cvt_pk_bf16(r1[0], r1[1]); w.w = cvt_pk_bf16(r1[2], r1[3]);
                *(u32x4*)rowp = w; }
    }
    __device__ __forceinline__ void operator()(const f32x4 (&acc)[2][2][4][2], const Unit& u, int wr, int wc, int fr, int fq) const { store(acc, u, wr, wc, fr, fq); }
};
struct EpiIn {
    static constexpr bool PERM = true, AFTER_DRAIN = false;
    bf16_t* GLU; bf16_t* QK; bf16_t* VT; int ldvt;
    static constexpr int VT_PM = 40, VT_PN = 48;
    __device__ __forceinline__ void operator()(const f32x4 (&acc)[2][2][4][2], const Unit& u, int wr, int wc, int fr, int fq) const {
        if (u.pn < 4) { EpiGate<0> g{GLU, 512}; g.store(acc, u, wr, wc, fr, fq); }
        else {
            const bool vt = u.pn >= VT_PN;
            const int row0 = (vt ? u.pm + VT_PM : u.pm) * BM + wr * 64 + fr, col0 = (vt ? u.pn - VT_PN : u.pn - 4) * BM + wc * 32 + 8 * fq;
            bf16_t* const OB = vt ? VT : QK; const size_t ld = vt ? (size_t)ldvt : (size_t)1024;
#pragma unroll
            for (int ai = 0; ai < 2; ++ai)
#pragma unroll
                for (int m = 0; m < 4; ++m) { bf16_t* rowp = OB + (size_t)(row0 + ai * HALF + m * 16) * ld + col0;
#pragma unroll
                    for (int bj = 0; bj < 2; ++bj) { const f32x4 v0 = acc[ai][bj][m][0], v1 = acc[ai][bj][m][1];
                        u32x4 w; w.x = cvt_pk_bf16(v0[0], v0[1]); w.y = cvt_pk_bf16(v0[2], v0[3]); w.z = cvt_pk_bf16(v1[0], v1[1]); w.w = cvt_pk_bf16(v1[2], v1[3]);
                        *(u32x4*)(rowp + bj * HALF) = w; } }
        }
    }
};
struct EpiF32 {
    static constexpr bool PERM = false, AFTER_DRAIN = false;
    float* C; int ldc;
    __device__ __forceinline__ void operator()(const f32x4 (&acc)[2][2][4][2], const Unit& u, int wr, int wc, int fr, int fq) const {
        const int col0 = u.pn * BM + wc * 32 + 4 * fq;
#pragma unroll
        for (int ai = 0; ai < 2; ++ai)
#pragma unroll
            for (int m = 0; m < 4; ++m) { float* rowp = C + (size_t)(u.pm * BM + ai * HALF + wr * 64 + m * 16 + fr) * ldc + col0;
#pragma unroll
                for (int bj = 0; bj < 2; ++bj)
#pragma unroll
                    for (int n = 0; n < 2; ++n) *(f32x4*)(rowp + bj * HALF + n * 16) = acc[ai][bj][m][n]; }
    }
};

template <class Epi, class Sched, bool ALIGN_EPI = false, bool SP2 = false>
__device__ __forceinline__ void gemm_phase(PG8_LAS unsigned char* lds, const Gemm g, const Sched& S, const Epi& E) {
    const int tid = threadIdx.x, wid = __builtin_amdgcn_readfirstlane(tid >> 6), lane = tid & 63, wr = wid >> 2, wc = wid & 3, fr = lane & 15, fq = lane >> 4;
    const int K = g.K, nt = K / BK;
    unsigned voffA[2], voffB[2];
#pragma unroll
    for (int i = 0; i < 2; ++i) { int R, C; stage_rc(tid * 16 + i * 8192, R, C); const int Rb = Epi::PERM ? ((R & ~31) + perm32(R & 31)) : R;
        voffA[i] = (unsigned)(R * K + C) * 2u; voffB[i] = (unsigned)(Rb * K + C) * 2u; }
    const size_t kstep = (size_t)(BK * 2);
    const size_t hstep = (size_t)HALF * K * 2;
    const size_t tstep = 2 * hstep;
    const unsigned ldsw = (unsigned)wid * 1024u;
    const int aoff = lds_byte(wr * 64 + fr, fq * 8), boff = lds_byte(wc * 32 + fr, fq * 8);
#define PG8_SA(b, h) (((b) * 2 + (h)) * HTB)
#define PG8_SB(b, h) ((4 + (b) * 2 + (h)) * HTB)
#define PG8_STAGE(bufoff, gbase, voff) do { _Pragma("unroll") for (int _i = 0; _i < 2; ++_i) \
        __builtin_amdgcn_global_load_lds((const unsigned*)((const char*)(gbase) + (voff)[_i]), (PG8_LAS unsigned*)(lds + (bufoff) + ldsw + _i * 8192), 16, 0, 0); } while (0)
#define PG8_LDA(dst, b, h) do { _Pragma("unroll") for (int m = 0; m < 4; ++m) _Pragma("unroll") for (int k = 0; k < 2; ++k) dst[m][k] = *(const PG8_LAS bf16x8*)(lds + PG8_SA(b, h) + aoff + m * 2048 + k * 1024); } while (0)
#define PG8_LDB(dst, b, h) do { _Pragma("unroll") for (int n = 0; n < 2; ++n) _Pragma("unroll") for (int k = 0; k < 2; ++k) dst[n][k] = *(const PG8_LAS bf16x8*)(lds + PG8_SB(b, h) + boff + n * 2048 + k * 1024); } while (0)
#define PG8_MMA(ai, bj, At, Bt) do { __builtin_amdgcn_s_setprio(1); _Pragma("unroll") for (int m = 0; m < 4; ++m) _Pragma("unroll") for (int n = 0; n < 2; ++n) _Pragma("unroll") for (int k = 0; k < 2; ++k) \
        acc[ai][bj][m][n] = __builtin_amdgcn_mfma_f32_16x16x32_bf16(Bt[n][k], At[m][k], acc[ai][bj][m][n], 0, 0, 0); __builtin_amdgcn_s_setprio(0); } while (0)
#define PG8_WAIT_V(n) asm volatile("s_waitcnt vmcnt(" #n ")" ::: "memory")
#define PG8_WAIT_L(n) asm volatile("s_waitcnt lgkmcnt(" #n ")" ::: "memory")
#define PG8_BAR __builtin_amdgcn_s_barrier()
#define PG8_SCHED __builtin_amdgcn_sched_barrier(0)
    Unit cur, nxt; int ui = 0;
    if (!S.next(0, cur)) return;
    f32x4 acc[2][2][4][2];
#pragma unroll
    for (int a = 0; a < 2; ++a)
#pragma unroll
        for (int b = 0; b < 2; ++b)
#pragma unroll
            for (int m = 0; m < 4; ++m)
#pragma unroll
                for (int n = 0; n < 2; ++n) acc[a][b][m][n] = (f32x4){0.f, 0.f, 0.f, 0.f};
    bf16x8 At[4][2], B0[2][2], B1[2][2];
    const char* cA = (const char*)g.A + (size_t)cur.pm * tstep; const char* cB = (const char*)g.Bt + (size_t)cur.pn * tstep;
    S.a_ready(cur);
    if constexpr (SP2) {
        PG8_STAGE(PG8_SB(0, 0), cB, voffB); PG8_STAGE(PG8_SB(0, 1), cB + hstep, voffB); PG8_STAGE(PG8_SA(0, 0), cA, voffA); PG8_STAGE(PG8_SA(0, 1), cA + hstep, voffA);
        if (wr == 1) PG8_BAR;
        PG8_WAIT_V(2); PG8_BAR;
        PG8_STAGE(PG8_SB(1, 0), cB + kstep, voffB); PG8_STAGE(PG8_SA(1, 0), cA + kstep, voffA); PG8_STAGE(PG8_SB(1, 1), cB + hstep + kstep, voffB);
        PG8_WAIT_V(6); PG8_BAR;
    } else {
        PG8_STAGE(PG8_SB(0, 0), cB, voffB); PG8_STAGE(PG8_SA(0, 0), cA, voffA); PG8_STAGE(PG8_SB(0, 1), cB + hstep, voffB); PG8_STAGE(PG8_SA(0, 1), cA + hstep, voffA);
        if (wr == 1) PG8_BAR;
        PG8_WAIT_V(4); PG8_BAR;
        PG8_STAGE(PG8_SB(1, 0), cB + kstep, voffB); PG8_STAGE(PG8_SA(1, 0), cA + kstep, voffA); PG8_STAGE(PG8_SB(1, 1), cB + hstep + kstep, voffB);
        PG8_WAIT_V(6); PG8_BAR;
    }
    for (;;) {
        const bool has_next = S.next(ui + 1, nxt);
        const char* nA = has_next ? (const char*)g.A + (size_t)nxt.pm * tstep : cA; const char* nB = has_next ? (const char*)g.Bt + (size_t)nxt.pn * tstep : cB;
        for (int t = 0; t < nt; t += 2) {
            const bool last = (t == nt - 2);
            const char* a1 = cA + (size_t)(t + 1) * kstep;
            const char* a2 = last ? nA : cA + (size_t)(t + 2) * kstep; const char* b2 = last ? nB : cB + (size_t)(t + 2) * kstep;
            const char* a3 = a2 + kstep; const char* b3 = b2 + kstep;
            if (last && has_next) S.a_ready(nxt);
            if constexpr (SP2) {
            PG8_LDB(B0, 0, 0); PG8_LDB(B1, 0, 1); PG8_SCHED; PG8_LDA(At, 0, 0); PG8_STAGE(PG8_SA(1, 1), a1 + hstep, voffA);
            PG8_WAIT_V(8); PG8_WAIT_L(0); PG8_BAR; PG8_MMA(0, 0, At, B0); PG8_MMA(0, 1, At, B1); PG8_BAR; PG8_SCHED;
            PG8_LDA(At, 0, 1); PG8_STAGE(PG8_SB(0, 0), b2, voffB); PG8_STAGE(PG8_SB(0, 1), b2 + hstep, voffB); PG8_STAGE(PG8_SA(0, 0), a2, voffA);
            PG8_WAIT_V(8); PG8_WAIT_L(0); PG8_BAR; PG8_MMA(1, 0, At, B0); PG8_MMA(1, 1, At, B1); PG8_BAR; PG8_SCHED;
            PG8_LDB(B0, 1, 0); PG8_LDB(B1, 1, 1); PG8_SCHED; PG8_LDA(At, 1, 0); PG8_STAGE(PG8_SA(0, 1), a2 + hstep, voffA);
            PG8_WAIT_V(8); PG8_WAIT_L(0); PG8_BAR; PG8_MMA(0, 0, At, B0); PG8_MMA(0, 1, At, B1); PG8_BAR; PG8_SCHED;
            PG8_LDA(At, 1, 1); PG8_STAGE(PG8_SB(1, 0), b3, voffB); PG8_STAGE(PG8_SB(1, 1), b3 + hstep, voffB); PG8_STAGE(PG8_SA(1, 0), a3, voffA);
            PG8_WAIT_V(8); PG8_WAIT_L(0); PG8_BAR; PG8_MMA(1, 0, At, B0); PG8_MMA(1, 1, At, B1); PG8_BAR; PG8_SCHED;
            } else {
            PG8_LDB(B0, 0, 0); PG8_SCHED; PG8_LDA(At, 0, 0); PG8_STAGE(PG8_SA(1, 1), a1 + hstep, voffA);
            PG8_WAIT_L(8); PG8_BAR; PG8_WAIT_L(0); PG8_MMA(0, 0, At, B0); PG8_BAR; PG8_SCHED;
            PG8_LDB(B1, 0, 1); PG8_STAGE(PG8_SB(0, 0), b2, voffB);
            PG8_BAR; PG8_WAIT_L(0); PG8_MMA(0, 1, At, B1); PG8_BAR;
            PG8_LDA(At, 0, 1); PG8_STAGE(PG8_SA(0, 0), a2, voffA);
            PG8_BAR; PG8_WAIT_L(0); PG8_MMA(1, 0, At, B0); PG8_BAR; PG8_SCHED;
            PG8_STAGE(PG8_SB(0, 1), b2 + hstep, voffB);
            PG8_WAIT_V(6); PG8_BAR; PG8_MMA(1, 1, At, B1); PG8_BAR;
            PG8_LDB(B0, 1, 0); PG8_SCHED; PG8_LDA(At, 1, 0); PG8_STAGE(PG8_SA(0, 1), a2 + hstep, voffA);
            PG8_WAIT_L(8); PG8_BAR; PG8_WAIT_L(0); PG8_MMA(0, 0, At, B0); PG8_BAR; PG8_SCHED;
            PG8_LDB(B1, 1, 1); PG8_STAGE(PG8_SB(1, 0), b3, voffB);
            PG8_BAR; PG8_WAIT_L(0); PG8_MMA(0, 1, At, B1); PG8_BAR;
            PG8_LDA(At, 1, 1); PG8_STAGE(PG8_SA(1, 0), a3, voffA);
            PG8_BAR; PG8_WAIT_L(0); PG8_MMA(1, 0, At, B0); PG8_BAR; PG8_SCHED;
            PG8_STAGE(PG8_SB(1, 1), b3 + hstep, voffB);
            PG8_WAIT_V(6); PG8_BAR; PG8_MMA(1, 1, At, B1); PG8_BAR;
            }
        }
        if constexpr (ALIGN_EPI) { if (wr == 0) PG8_BAR; }
        if constexpr (!Epi::AFTER_DRAIN) { E(acc, cur, wr, wc, fr, fq); S.done(cur); }
        if (!has_next) break;
#pragma unroll
        for (int a = 0; a < 2; ++a)
#pragma unroll
            for (int b = 0; b < 2; ++b)
#pragma unroll
                for (int m = 0; m < 4; ++m)
#pragma unroll
                    for (int n = 0; n < 2; ++n) acc[a][b][m][n] = (f32x4){0.f, 0.f, 0.f, 0.f};
        cur = nxt; cA = nA; cB = nB; ++ui;
        if constexpr (ALIGN_EPI) { if (wr == 1) PG8_BAR; }
    }
    PG8_WAIT_V(0);
    if constexpr (!ALIGN_EPI) { if (wr == 0) PG8_BAR; }
    PG8_BAR;
    if constexpr (Epi::AFTER_DRAIN) { E.fused(acc, cur, wr, wc, fr, fq, lds, wid, lane); S.done(cur); }
#undef PG8_SA
#undef PG8_SB
#undef PG8_STAGE
#undef PG8_LDA
#undef PG8_LDB
#undef PG8_MMA
#undef PG8_WAIT_V
#undef PG8_WAIT_L
#undef PG8_BAR
#undef PG8_SCHED
}
}

#define GAS __attribute__((address_space(1)))
#define LAS __attribute__((address_space(3)))
typedef unsigned short bf16;
typedef unsigned v4u __attribute__((ext_vector_type(4)));
typedef unsigned v2u __attribute__((ext_vector_type(2)));
typedef float f32x4 __attribute__((ext_vector_type(4)));
typedef float f32x16 __attribute__((ext_vector_type(16)));
typedef short bf16x8 __attribute__((ext_vector_type(8)));
typedef short s16x4 __attribute__((ext_vector_type(4)));
typedef float f32x2_t __attribute__((ext_vector_type(2)));
typedef __bf16 bf16x2_t __attribute__((ext_vector_type(2)));

constexpr int NWAVES = 8;
constexpr int BATCH = 4, SEQ = 8192, D = 1024, M = BATCH * SEQ;
constexpr int CONV_CH = 512, CONV_W = 31, NH = 8, HD = 64, FF = 2816, IN_COLS = 2560;
constexpr float EPS = 1e-6f;
constexpr float LOG2E = 1.4426950408889634f;

constexpr size_t MiB = 1u << 20;
constexpr size_t WS_WIN = 0, WS_WOUT = 5 * MiB, WS_WGU = 7 * MiB, WS_WD = 18 * MiB;
constexpr size_t WS_XN = 24 * MiB;
constexpr size_t WS_Y = 88 * MiB;
constexpr size_t WS_GLU = 216 * MiB;
constexpr size_t WS_QK = 248 * MiB;
constexpr size_t WS_VT = 312 * MiB;
constexpr size_t WS_MIX = 344 * MiB;
constexpr size_t WS_ACT = 216 * MiB;
constexpr size_t WS_CTL = 408 * MiB, CTL_BYTES = 16384;
constexpr size_t WS_R1 = 409 * MiB;
constexpr size_t WS_END = 410 * MiB;
static_assert(WS_ACT + (size_t)M * FF * 2 <= WS_END && WS_MIX + (size_t)M * D * 2 <= WS_END && WS_WD + (size_t)D * FF * 2 <= WS_XN, "ws map");

constexpr int LDS_BYTES = 147456;

__device__ __forceinline__ unsigned cvtpk(float lo, float hi) { f32x2_t v = {lo, hi}; bf16x2_t b = __builtin_convertvector(v, bf16x2_t); return __builtin_bit_cast(unsigned, b); }
__device__ __forceinline__ float bf_lo(unsigned u) { return __builtin_bit_cast(float, u << 16); }
__device__ __forceinline__ float bf_hi(unsigned u) { return __builtin_bit_cast(float, u & 0xffff0000u); }
template <int CTRL> __device__ __forceinline__ float dppf(float x) { return __builtin_bit_cast(float, __builtin_amdgcn_mov_dpp(__builtin_bit_cast(int, x), CTRL, 0xf, 0xf, true)); }
__device__ __forceinline__ void swap32(float& a, float& b) { asm volatile("v_nop\n\tv_nop\n\tv_permlane32_swap_b32 %0, %1" : "+v"(a), "+v"(b)); }
__device__ __forceinline__ void swap16(float& a, float& b) { asm volatile("v_nop\n\tv_nop\n\tv_permlane16_swap_b32 %0, %1" : "+v"(a), "+v"(b)); }
__device__ __forceinline__ float swap16_sum(float x) { float a = x, b = x; swap16(a, b); return a + b; }
__device__ __forceinline__ float swap32_sum(float x) { float a = x, b = x; swap32(a, b); return a + b; }
__device__ __forceinline__ float wave_sum(float v) {
    v += dppf<0xB1>(v);
    v += dppf<0x4E>(v);
    v += dppf<0x141>(v);
    v += dppf<0x128>(v);
    v = swap16_sum(v);
    return swap32_sum(v);
}
#define LDS_WAIT() asm volatile("s_waitcnt lgkmcnt(0)" ::: "memory")

struct Params {
    const float *x, *g_pre_mix, *w_in, *conv_w, *conv_b, *ln_g, *ln_b, *attn_g, *w_out, *g_post_mix, *g_pre_ffn, *w_gate, *w_up, *w_down, *g_post_ffn;
    float* out; unsigned char* ws;
};

__device__ __forceinline__ void transpose_item(const float* W, int K, int N, bf16* WT, int drow0, LAS float* scr, int kb, int nb, int lane, const float* gk = nullptr) {
    const int k0 = 64 * kb, n0 = 32 * nb;
#pragma unroll
    for (int i = 0; i < 32; ++i) { const int kk = 2 * i + (lane >> 5); scr[kk * 33 + (lane & 31)] = __builtin_nontemporal_load(W + (size_t)(k0 + kk) * N + n0 + (lane & 31)); }
    LDS_WAIT(); asm volatile("" ::: "memory");
    const int c = lane & 7;
    f32x4 ga = (f32x4){1.f, 1.f, 1.f, 1.f}, gb = ga;
    if (gk) { ga = *(const GAS f32x4*)(gk + k0 + 8 * c); gb = *(const GAS f32x4*)(gk + k0 + 8 * c + 4); }
#pragma unroll
    for (int j = 0; j < 4; ++j) { const int n = (lane >> 3) + 8 * j; const LAS float* s = scr + (8 * c) * 33 + n;
        v4u o; o.x = cvtpk(s[0 * 33] * ga.x, s[1 * 33] * ga.y); o.y = cvtpk(s[2 * 33] * ga.z, s[3 * 33] * ga.w); o.z = cvtpk(s[4 * 33] * gb.x, s[5 * 33] * gb.y); o.w = cvtpk(s[6 * 33] * gb.z, s[7 * 33] * gb.w);
        *(GAS v4u*)(WT + (size_t)(drow0 + n) * K + k0 + 8 * c) = o; }
    LDS_WAIT(); asm volatile("" ::: "memory");
}

constexpr int WI_IN = 16 * (IN_COLS / 32), WI_ALL = WI_IN + 16 * 32 + 2 * 16 * (FF / 32) + (FF / 64) * 32;
__device__ __forceinline__ void weight_items(const Params& p, LAS float* scr, int gw, int NGW, int lane, int it_lo, int it_hi) {
    bf16* Win_t = (bf16*)(p.ws + WS_WIN); bf16* Wout_t = (bf16*)(p.ws + WS_WOUT); bf16* Wgu_t = (bf16*)(p.ws + WS_WGU); bf16* Wd_t = (bf16*)(p.ws + WS_WD);
    constexpr int I_IN = 16 * (IN_COLS / 32), I_OUT = 16 * 32, I_G = 16 * (FF / 32), I_D = (FF / 64) * 32;
    constexpr int NITEMS = I_IN + I_OUT + 2 * I_G + I_D;
    static_assert(NITEMS == WI_ALL && I_IN == WI_IN, "item counts");
    for (int it = it_lo + gw; it < it_hi; it += NGW) {
        int r = it;
        if (r < I_IN) { const int nblk = IN_COLS / 32, kb = r / nblk, nb = r % nblk, n0 = 32 * nb; int dr;
            if (n0 < 512) dr = 256 * (n0 >> 7) + (n0 & 127); else if (n0 < 1024) dr = 256 * ((n0 - 512) >> 7) + 128 + (n0 & 127); else dr = n0;
            transpose_item(p.w_in, D, IN_COLS, Win_t, dr, scr, kb, nb, lane, p.g_pre_mix); continue; } r -= I_IN;
        if (r < I_OUT) { transpose_item(p.w_out, D, D, Wout_t, 32 * (r % 32), scr, r / 32, r % 32, lane); continue; } r -= I_OUT;
        if (r < I_G) { const int nblk = FF / 32, kb = r / nblk, nb = r % nblk, n0 = 32 * nb; transpose_item(p.w_gate, D, FF, Wgu_t, 256 * (n0 >> 7) + (n0 & 127), scr, kb, nb, lane, p.g_pre_ffn); continue; } r -= I_G;
        if (r < I_G) { const int nblk = FF / 32, kb = r / nblk, nb = r % nblk, n0 = 32 * nb; transpose_item(p.w_up, D, FF, Wgu_t, 256 * (n0 >> 7) + 128 + (n0 & 127), scr, kb, nb, lane, p.g_pre_ffn); continue; } r -= I_G;
        transpose_item(p.w_down, FF, D, Wd_t, 32 * (r % 32), scr, r / 32, r % 32, lane);
    }
}
__device__ __forceinline__ void phase_prologue(const Params& p, LAS unsigned char* lds, int gw, int NGW, int wave, int lane) {
    weight_items(p, (LAS float*)(lds + wave * 16384), gw, NGW, lane, 0, WI_IN);
    bf16* XN = (bf16*)(p.ws + WS_XN); float* R0 = (float*)(p.ws + WS_R1);
    for (int m = gw; m < M; m += NGW) {
        const GAS f32x4* xr = (const GAS f32x4*)(p.x + (size_t)m * D) + lane;
        f32x4 v[4]; float s = 0.f;
#pragma unroll
        for (int j = 0; j < 4; ++j) { v[j] = __builtin_nontemporal_load(xr + 64 * j); s += (v[j].x * v[j].x + v[j].y * v[j].y) + (v[j].z * v[j].z + v[j].w * v[j].w); }
        const float rms = sqrtf(wave_sum(s) * (1.f / D) + EPS), rstd = 1.0f / rms;
        if (lane == 0) R0[m] = rms;
        GAS v2u* o8 = (GAS v2u*)(XN + (size_t)m * D) + lane;
#pragma unroll
        for (int j = 0; j < 4; ++j) { v2u o; o.x = cvtpk(v[j].x * rstd, v[j].y * rstd); o.y = cvtpk(v[j].z * rstd, v[j].w * rstd); o8[64 * j] = o; }
    }
}

constexpr int CV_T = 32, CV_IN_ROWS = CV_T + CONV_W - 1, CV_IN_BYTES = CV_IN_ROWS * CONV_CH * 2, CV_OUT_OFF = CV_IN_BYTES;
static_assert(CV_OUT_OFF + CV_T * CONV_CH * 4 <= 131072 && (CV_OUT_OFF % 16) == 0, "conv LDS map");
__device__ __forceinline__ void phase_conv(const Params& p, LAS unsigned char* lds, int bid, int G, int tid, int wave, int lane) {
    const bf16* GLU = (const bf16*)(p.ws + WS_GLU); bf16* MIX = (bf16*)(p.ws + WS_MIX);
    const int cp = tid & 255, half = tid >> 8;
    float cw0[CONV_W], cw1[CONV_W];
#pragma unroll
    for (int w = 0; w < CONV_W; ++w) { cw0[w] = p.conv_w[w * CONV_CH + 2 * cp]; cw1[w] = p.conv_w[w * CONV_CH + 2 * cp + 1]; }
    const float cb0 = p.conv_b[2 * cp], cb1 = p.conv_b[2 * cp + 1];
    LAS float* outp = (LAS float*)(lds + CV_OUT_OFF);
#define CV_LOAD(SV, TILE) do { const int tok0_ = (TILE) * CV_T, tin_ = tok0_ % SEQ; \
        _Pragma("unroll") for (int i = 0; i < 8; ++i) { const int ch = tid + i * (NWAVES * 64), rr = ch >> 6, c16 = ch & 63, t = tin_ - (CONV_W - 1) + rr; \
            SV[i] = (v4u){0u, 0u, 0u, 0u}; \
            if (ch < CV_IN_ROWS * 64 && t >= 0) SV[i] = *(const GAS v4u*)(GLU + (size_t)(tok0_ - (CONV_W - 1) + rr) * CONV_CH + c16 * 8); } } while (0)
    v4u sv[8];
    if (bid < M / CV_T) CV_LOAD(sv, bid);
    for (int tile = bid; tile < M / CV_T; tile += G) {
        const int tok0 = tile * CV_T;
#pragma unroll
        for (int i = 0; i < 8; ++i) { const int ch = tid + i * (NWAVES * 64), rr = ch >> 6, c16 = ch & 63;
            if (ch < CV_IN_ROWS * 64) *(LAS v4u*)(lds + rr * 1024 + c16 * 16) = sv[i]; }
        if (tile + G < M / CV_T) CV_LOAD(sv, tile + G);
        __syncthreads();
#pragma unroll
        for (int ob = 0; ob < 2; ++ob) {
            const int o0 = 16 * half + 8 * ob;
            float a0[8], a1[8];
#pragma unroll
            for (int o = 0; o < 8; ++o) { a0[o] = cb0; a1[o] = cb1; }
#pragma unroll
            for (int j = 0; j < 8 + CONV_W - 1; ++j) {
                const unsigned u = *(const LAS unsigned*)(lds + (o0 + j) * 1024 + cp * 4);
                const float v0 = bf_lo(u), v1 = bf_hi(u);
#pragma unroll
                for (int o = 0; o < 8; ++o) { const int w = j - o; if (w >= 0 && w < CONV_W) { a0[o] += v0 * cw0[w]; a1[o] += v1 * cw1[w]; } }
            }
#pragma unroll
            for (int o = 0; o < 8; ++o) *(LAS f32x2_t*)(outp + (o0 + o) * CONV_CH + 2 * cp) = (f32x2_t){a0[o], a1[o]};
        }
        __syncthreads();
        { f32x4 lg[2], lb[2];
#pragma unroll
          for (int j = 0; j < 2; ++j) { lg[j] = *((const GAS f32x4*)p.ln_g + 2 * lane + j); lb[j] = *((const GAS f32x4*)p.ln_b + 2 * lane + j); }
          f32x4 v0[4], v1[4]; float sm[4], sq[4];
#pragma unroll
          for (int q = 0; q < 4; ++q) { const int tk = wave + 8 * q;
              v0[q] = *(const LAS f32x4*)(outp + tk * CONV_CH + 8 * lane); v1[q] = *(const LAS f32x4*)(outp + tk * CONV_CH + 8 * lane + 4);
              sm[q] = (v0[q].x + v0[q].y) + (v0[q].z + v0[q].w) + (v1[q].x + v1[q].y) + (v1[q].z + v1[q].w); }
#pragma unroll
          for (int q = 0; q < 4; ++q) sm[q] = wave_sum(sm[q]);
#pragma unroll
          for (int q = 0; q < 4; ++q) { const float mu = sm[q] * (1.f / CONV_CH); v0[q] = v0[q] - mu; v1[q] = v1[q] - mu;
              sq[q] = (v0[q].x * v0[q].x + v0[q].y * v0[q].y) + (v0[q].z * v0[q].z + v0[q].w * v0[q].w) + (v1[q].x * v1[q].x + v1[q].y * v1[q].y) + (v1[q].z * v1[q].z + v1[q].w * v1[q].w); }
#pragma unroll
          for (int q = 0; q < 4; ++q) sq[q] = wave_sum(sq[q]);
#pragma unroll
          for (int q = 0; q < 4; ++q) { const int tk = wave + 8 * q;
              const float rstd = 1.0f / sqrtf(sq[q] * (1.f / CONV_CH) + EPS);
              f32x4 y0 = v0[q] * rstd * lg[0] + lb[0], y1 = v1[q] * rstd * lg[1] + lb[1];
#pragma unroll
              for (int i = 0; i < 4; ++i) { y0[i] = y0[i] * pg8::sigm(y0[i]); y1[i] = y1[i] * pg8::sigm(y1[i]); }
              v4u o; o.x = cvtpk(y0.x, y0.y); o.y = cvtpk(y0.z, y0.w); o.z = cvtpk(y1.x, y1.y); o.w = cvtpk(y1.z, y1.w);
              *(GAS v4u*)(MIX + (size_t)(tok0 + tk) * D + 8 * lane) = o; } }
        __syncthreads();
    }
}

#define MFMA32(a, b, c) __builtin_amdgcn_mfma_f32_32x32x16_bf16((a), (b), (c), 0, 0, 0)
constexpr int AT_KP = 144, AT_VP = 80, AT_KB = 32 * AT_KP, AT_WB = AT_KB + 64 * AT_VP;
static_assert(8 * AT_WB <= 131072 && (AT_WB % 16) == 0, "attention LDS map");
__device__ __forceinline__ void attn_unit(const bf16* QK, const bf16* VT, bf16* MIX, const float* attn_g, int b, int h, int qt, int lane, LAS unsigned char* wl) {
    const int r = lane & 31, hf = lane >> 5;
    const size_t tok0 = (size_t)b * SEQ + (size_t)qt * 32;
    bf16x8 qf[4];
    { const bf16* qp = QK + (tok0 + r) * 1024 + h * 64 + 8 * hf;
#pragma unroll
      for (int s = 0; s < 4; ++s) qf[s] = *(const GAS bf16x8*)(qp + 16 * s); }
    f32x16 o0, o1;
#pragma unroll
    for (int i = 0; i < 16; ++i) { o0[i] = 0.f; o1[i] = 0.f; }
    float carry = 0.f;
    constexpr float ZS = 0.125f * LOG2E;
    const bf16* kg = QK + ((size_t)b * SEQ + (lane >> 3)) * 1024 + 512 + h * 64 + (lane & 7) * 8;
    const bf16* vg = VT + (size_t)(h * 64 + (lane >> 2)) * M + (size_t)b * SEQ + (lane & 3) * 8;
    LAS unsigned char* kw = wl + (lane >> 3) * AT_KP + (lane & 7) * 16;
    LAS unsigned char* vw = wl + AT_KB + (lane >> 2) * AT_VP + (lane & 3) * 16;
    const int pr = (r & 0x13) | ((r & 4) << 1) | ((r & 8) >> 1);
    const LAS unsigned char* kr = wl + pr * AT_KP + 16 * hf;
    const LAS unsigned char* vr = wl + AT_KB + r * AT_VP + 16 * hf;
#define ATT_LOAD(SK, SV, KB) do { _Pragma("unroll") for (int i = 0; i < 4; ++i) { \
        SK[i] = *(const GAS v4u*)(kg + (size_t)((KB) + 8 * i) * 1024); SV[i] = *(const GAS v4u*)(vg + (size_t)(16 * i) * M + (KB)); } } while (0)
    v4u sk[4], sv[4];
    ATT_LOAD(sk, sv, qt * 32);
    for (int kb = qt * 32; kb >= 0; kb -= 32) {
#pragma unroll
        for (int i = 0; i < 4; ++i) { *(LAS v4u*)(kw + 8 * i * AT_KP) = sk[i]; *(LAS v4u*)(vw + 16 * i * AT_VP) = sv[i]; }
        if (kb >= 32) ATT_LOAD(sk, sv, kb - 32);
        bf16x8 kf[4], vf[2][2];
#pragma unroll
        for (int s = 0; s < 4; ++s) kf[s] = *(const LAS bf16x8*)(kr + 32 * s);
#pragma unroll
        for (int db = 0; db < 2; ++db)
#pragma unroll
            for (int s = 0; s < 2; ++s) vf[db][s] = *(const LAS bf16x8*)(vr + db * 32 * AT_VP + 32 * s);
        f32x16 st;
#pragma unroll
        for (int i = 0; i < 16; ++i) st[i] = 0.f;
#pragma unroll
        for (int s = 0; s < 4; ++s) st = MFMA32(kf[s], qf[s], st);
        const bool diag = (kb == qt * 32);
        float lbv[16], l1[16];
#pragma unroll
        for (int i = 0; i < 16; ++i) {
            const float z = st[i] * ZS;
            const float L = __builtin_amdgcn_logf(1.0f + __builtin_amdgcn_exp2f(-fabsf(z)));
            lbv[i] = fminf(z, 0.f) - L;
            l1[i] = fminf(-z, 0.f) - L;
            if (diag) { const int key = 16 * (i >> 3) + 8 * hf + (i & 7); if (key >= r) { l1[i] = 0.f; lbv[i] = -1e30f; } }
        }
        float e[16], tot[2], pt[2];
#pragma unroll
        for (int a = 0; a < 2; ++a) { e[8 * a + 7] = 0.f;
#pragma unroll
            for (int j = 6; j >= 0; --j) e[8 * a + j] = e[8 * a + j + 1] + l1[8 * a + j + 1];
            tot[a] = e[8 * a] + l1[8 * a]; }
#pragma unroll
        for (int a = 0; a < 2; ++a) { float lo_ = tot[a], hi_ = tot[a]; swap32(lo_, hi_); tot[a] = lo_; pt[a] = hi_; }
        const float pair1 = tot[1] + pt[1], btot = (tot[0] + pt[0]) + pair1;
        float off[2];
        off[1] = carry + (hf == 0 ? pt[1] : 0.f); off[0] = carry + pair1 + (hf == 0 ? pt[0] : 0.f);
        float pv[16];
#pragma unroll
        for (int i = 0; i < 16; ++i) pv[i] = __builtin_amdgcn_exp2f(lbv[i] + (off[i >> 3] + e[i]));
        bf16x8 pk[2];
#pragma unroll
        for (int s = 0; s < 2; ++s) { v4u w; w.x = cvtpk(pv[8 * s], pv[8 * s + 1]); w.y = cvtpk(pv[8 * s + 2], pv[8 * s + 3]); w.z = cvtpk(pv[8 * s + 4], pv[8 * s + 5]); w.w = cvtpk(pv[8 * s + 6], pv[8 * s + 7]); pk[s] = __builtin_bit_cast(bf16x8, w); }
        o0 = MFMA32(vf[0][0], pk[0], o0); o0 = MFMA32(vf[0][1], pk[1], o0);
        o1 = MFMA32(vf[1][0], pk[0], o1); o1 = MFMA32(vf[1][1], pk[1], o1);
        carry += btot;
        if (__all(carry < -160.f)) break;
    }
#undef ATT_LOAD
    float ss = 0.f;
#pragma unroll
    for (int i = 0; i < 16; ++i) ss += o0[i] * o0[i] + o1[i] * o1[i];
    ss = swap32_sum(ss);
    const float rstd = 1.0f / sqrtf(ss * (1.f / HD) + EPS);
    bf16* op = MIX + (tok0 + r) * D + 512 + h * 64 + 4 * hf;
    const float* gp = attn_g + h * 64 + 4 * hf;
#pragma unroll
    for (int g = 0; g < 4; ++g) {
        const f32x4 g0 = *(const GAS f32x4*)(gp + 8 * g), g1 = *(const GAS f32x4*)(gp + 32 + 8 * g);
        v2u w0, w1;
        w0.x = cvtpk(o0[4 * g] * rstd * g0.x, o0[4 * g + 1] * rstd * g0.y); w0.y = cvtpk(o0[4 * g + 2] * rstd * g0.z, o0[4 * g + 3] * rstd * g0.w);
        w1.x = cvtpk(o1[4 * g] * rstd * g1.x, o1[4 * g + 1] * rstd * g1.y); w1.y = cvtpk(o1[4 * g + 2] * rstd * g1.z, o1[4 * g + 3] * rstd * g1.w);
        *(GAS v2u*)(op + 8 * g) = w0; *(GAS v2u*)(op + 32 + 8 * g) = w1;
    }
}
__device__ __forceinline__ void phase_attn(const Params& p, int gw, int NGW, int lane, LAS unsigned char* wl) {
    const bf16* QK = (const bf16*)(p.ws + WS_QK); const bf16* VT = (const bf16*)(p.ws + WS_VT); bf16* MIX = (bf16*)(p.ws + WS_MIX);
    constexpr int NQT = SEQ / 32, NUNITS = BATCH * NH * NQT;
    for (int u = gw; u < NUNITS; u += NGW) { const int qt = u % NQT, h = (u / NQT) % NH, b = u / (NQT * NH); attn_unit(QK, VT, MIX, p.attn_g, b, h, qt, lane, wl); }
}

__device__ __forceinline__ f32x4 ld_bf4(const bf16* row, int lane, int j) { const v2u u = *((const GAS v2u*)row + lane + 64 * j); return (f32x4){bf_lo(u.x), bf_hi(u.x), bf_lo(u.y), bf_hi(u.y)}; }
__device__ __forceinline__ f32x4 ld_bf4_nt(const bf16* row, int lane, int j) { const v2u u = __builtin_nontemporal_load((const GAS v2u*)row + lane + 64 * j); return (f32x4){bf_lo(u.x), bf_hi(u.x), bf_lo(u.y), bf_hi(u.y)}; }
__device__ __forceinline__ float ssq4(const f32x4 v) { return (v.x * v.x + v.y * v.y) + (v.z * v.z + v.w * v.w); }
__device__ __forceinline__ void phase_mid_rows(const Params& p, int gw, int NGW, int lane) {
    const bf16* YB = (const bf16*)(p.ws + WS_Y); bf16* XN = (bf16*)(p.ws + WS_XN); float* R0 = (float*)(p.ws + WS_R1);
    f32x4 g1[4];
#pragma unroll
    for (int j = 0; j < 4; ++j) g1[j] = *((const GAS f32x4*)p.g_post_mix + lane + 64 * j);
    for (int m = gw; m < M; m += NGW) {
        const float rx = R0[m];
        f32x4 y[4], x[4]; float s = 0.f;
#pragma unroll
        for (int j = 0; j < 4; ++j) { y[j] = ld_bf4_nt(YB + (size_t)m * D, lane, j); x[j] = ld_bf4(XN + (size_t)m * D, lane, j); s += ssq4(y[j]); }
        const float r1 = 1.0f / sqrtf(wave_sum(s) * (1.f / D) + EPS);
        float s2 = 0.f;
#pragma unroll
        for (int j = 0; j < 4; ++j) { x[j] = x[j] * rx + y[j] * r1 * g1[j]; s2 += ssq4(x[j]); }
        const float rms2 = sqrtf(wave_sum(s2) * (1.f / D) + EPS), r2 = 1.0f / rms2;
        if (lane == 0) R0[m] = rms2;
        GAS v2u* o8 = (GAS v2u*)(XN + (size_t)m * D) + lane;
#pragma unroll
        for (int j = 0; j < 4; ++j) { const f32x4 f = x[j] * r2; v2u o; o.x = cvtpk(f.x, f.y); o.y = cvtpk(f.z, f.w); o8[64 * j] = o; }
    }
}
__device__ __forceinline__ void phase_final_rows(const Params& p, int gw, int NGW, int lane) {
    const bf16* XN = (const bf16*)(p.ws + WS_XN); const bf16* FB = (const bf16*)(p.ws + WS_Y + 64 * MiB); const float* R0 = (const float*)(p.ws + WS_R1);
    f32x4 g3[4];
#pragma unroll
    for (int j = 0; j < 4; ++j) g3[j] = *((const GAS f32x4*)p.g_post_ffn + lane + 64 * j);
    for (int m = gw; m < M; m += NGW) {
        GAS f32x4* orow = (GAS f32x4*)(p.out + (size_t)m * D) + lane;
        const float rh = R0[m];
        f32x4 f[4], h[4]; float sf = 0.f;
#pragma unroll
        for (int j = 0; j < 4; ++j) { f[j] = ld_bf4_nt(FB + (size_t)m * D, lane, j); h[j] = ld_bf4_nt(XN + (size_t)m * D, lane, j); sf += ssq4(f[j]); }
        const float r3 = 1.0f / sqrtf(wave_sum(sf) * (1.f / D) + EPS);
#pragma unroll
        for (int j = 0; j < 4; ++j) __builtin_nontemporal_store(h[j] * rh + f[j] * r3 * g3[j], orow + 64 * j);
    }
}

#define RLX_AGENT __ATOMIC_RELAXED, __HIP_MEMORY_SCOPE_AGENT
#define XB_TMO      128
#define XB_XCNT(j)  (256  + 64 * (j))
#define XB_XSUB(j)  (1280 + 64 * (j))
#define XB_XGEN(j)  (2304 + 64 * (j))
#define XB_TOP      3328
#define XB_TOPGEN   3392
#define XCD_BAR_WORDS 3456
#define XB_SPIN_CAP (1u << 18)

__device__ __forceinline__ unsigned xb_ld(unsigned* p)              { return __hip_atomic_load(p, __ATOMIC_RELAXED, __HIP_MEMORY_SCOPE_AGENT); }
__device__ __forceinline__ unsigned xb_add(unsigned* p, unsigned v) { return __hip_atomic_fetch_add(p, v, __ATOMIC_RELAXED, __HIP_MEMORY_SCOPE_AGENT); }
__device__ __forceinline__ unsigned xb_xcc_id() { return (unsigned)__builtin_amdgcn_s_getreg((3 << 11) | 20) & 0xFu; }
#define XB_SPIN(cond, bar) do { unsigned _sp = 0; while (cond) { __builtin_amdgcn_s_sleep(1); \
    if ((++_sp & 255u) == 0u) { if (xb_ld(&(bar)[XB_TMO])) break; if (_sp > XB_SPIN_CAP) { atomicAdd(&(bar)[XB_TMO], 1u); break; } } } } while (0)

struct XcdBarrier {
    unsigned* bar; unsigned x;
    volatile LAS unsigned* st;
};

__device__ __forceinline__ XcdBarrier xcd_barrier_post(unsigned* bar, volatile LAS unsigned* st) {
    XcdBarrier b; b.bar = bar; b.x = xb_xcc_id(); b.st = st;
    if (threadIdx.x == 0) (void)xb_add(&bar[XB_XCNT(b.x)], 1u);
    return b;
}
__device__ __forceinline__ void xcd_barrier_complete(unsigned* bar, unsigned x, unsigned& nloc, unsigned& nx) {
    const unsigned G = gridDim.x * gridDim.y * gridDim.z;
    unsigned sum, cnt, mine, sp = 0u;
    for (;;) {
        sum = 0u; cnt = 0u; mine = 0u;
#pragma unroll
        for (unsigned j = 0; j < 16; ++j) { const unsigned c = xb_ld(&bar[XB_XCNT(j)]); sum += c; cnt += (c > 0u) ? 1u : 0u; mine = (j == x) ? c : mine; }
        if (sum == G) break;
        __builtin_amdgcn_s_sleep(1);
        if ((++sp & 255u) == 0u) { if (xb_ld(&bar[XB_TMO])) break; if (sp > XB_SPIN_CAP) { atomicAdd(&bar[XB_TMO], 1u); break; } }
    }
    nloc = mine > 0u ? mine : 1u; nx = cnt > 0u ? cnt : 1u;
}

__device__ __forceinline__ void xcd_barrier(const XcdBarrier& b) {
    asm volatile("s_waitcnt vmcnt(0)" ::: "memory");
    __syncthreads();
    if (threadIdx.x == 0) {
        unsigned* bar = b.bar;
        __builtin_amdgcn_s_waitcnt(0);
        unsigned nloc = b.st[0], nx = b.st[1];
        if (nloc == 0u) { xcd_barrier_complete(bar, b.x, nloc, nx); b.st[0] = nloc; b.st[1] = nx; }
        const unsigned old = xb_add(&bar[XB_XSUB(b.x)], 1u);
        const unsigned gen = old / nloc;
        if (old + 1u == (gen + 1u) * nloc) {
            __builtin_amdgcn_fence(__ATOMIC_RELEASE, "agent");
            asm volatile("s_waitcnt vmcnt(0)" ::: "memory");
            const unsigned og = xb_add(&bar[XB_TOP], 1u);
            const unsigned tg = og / nx;
            if (og + 1u == (tg + 1u) * nx) xb_add(&bar[XB_TOPGEN], 1u);
            else XB_SPIN(xb_ld(&bar[XB_TOPGEN]) == tg, bar);
            __builtin_amdgcn_fence(__ATOMIC_ACQUIRE, "agent");
            xb_add(&bar[XB_XGEN(b.x)], 1u);
            asm volatile("s_waitcnt vmcnt(0)" ::: "memory");
        } else {
            XB_SPIN(xb_ld(&bar[XB_XGEN(b.x)]) == gen, bar);
            __builtin_amdgcn_fence(__ATOMIC_ACQUIRE, "agent");
            asm volatile("s_waitcnt vmcnt(0)" ::: "memory");
        }
    }
    __syncthreads();
}

__global__ void __launch_bounds__(NWAVES * 64, 2) fwd_megakernel(Params p) {
    extern __shared__ __attribute__((aligned(16))) unsigned char lds_raw[];
    cg::grid_group grid = cg::this_grid();
    LAS unsigned char* lds = (LAS unsigned char*)lds_raw;
    const int tid = threadIdx.x, lane = tid & 63, wave = __builtin_amdgcn_readfirstlane(tid >> 6);
    const int G = gridDim.x, bid = blockIdx.x, gw = bid * NWAVES + wave, NGW = G * NWAVES;
    bf16* Win_t = (bf16*)(p.ws + WS_WIN); bf16* Wout_t = (bf16*)(p.ws + WS_WOUT); bf16* Wgu_t = (bf16*)(p.ws + WS_WGU); bf16* Wd_t = (bf16*)(p.ws + WS_WD);
    bf16* XN = (bf16*)(p.ws + WS_XN); float* Y = (float*)(p.ws + WS_Y); bf16* GLU = (bf16*)(p.ws + WS_GLU); bf16* QK = (bf16*)(p.ws + WS_QK);
    bf16* VT = (bf16*)(p.ws + WS_VT); bf16* MIX = (bf16*)(p.ws + WS_MIX); bf16* ACT = (bf16*)(p.ws + WS_ACT);

    volatile LAS unsigned* MISC = (volatile LAS unsigned*)(lds + 131072 + 320);
    if (tid < 32) MISC[tid] = 0u;
    __syncthreads();
    XcdBarrier bar = xcd_barrier_post((unsigned*)(p.ws + WS_CTL), MISC + 8);
    if (p.out == nullptr) grid.sync();
#define GRID_BAR() xcd_barrier(bar)
    phase_prologue(p, lds, gw, NGW, wave, lane);
    GRID_BAR();
    { static_assert(WS_WIN + (size_t)2048 * D * 2 + 40 * (size_t)(256 * D * 2) == WS_XN && WS_WIN + 48 * (size_t)(256 * D * 2) == WS_XN, "OrderIn tile shifts");
      pg8::Gemm g{XN, Win_t, M, IN_COLS, D}; pg8::OrderIn S{G, bid}; pg8::EpiIn E{GLU, QK, VT, M};
      pg8::gemm_phase<pg8::EpiIn, pg8::OrderIn, true, true>(lds, g, S, E); }
    GRID_BAR();
    phase_conv(p, lds, bid, G, tid, wave, lane);
    phase_attn(p, gw, NGW, lane, lds + wave * AT_WB);
    weight_items(p, (LAS float*)(lds + wave * AT_WB), gw, NGW, lane, WI_IN, WI_ALL);
    GRID_BAR();
    { pg8::Gemm g{MIX, Wout_t, M, D, D}; pg8::StaticOrder S; S.init(M, D, G, bid); pg8::EpiBf16<0> E{(bf16*)Y, D, nullptr, 0, 0, 1.f};
      pg8::gemm_phase<pg8::EpiBf16<0>, pg8::StaticOrder, true, true>(lds, g, S, E); }
    GRID_BAR();
    phase_mid_rows(p, gw, NGW, lane);
    GRID_BAR();
    { pg8::Gemm g{XN, Wgu_t, M, 2 * FF, D}; pg8::StaticOrder S; S.init(M, 2 * FF, G, bid); pg8::EpiGate<1> E{ACT, FF};
      pg8::gemm_phase<pg8::EpiGate<1>, pg8::StaticOrder, true, true>(lds, g, S, E); }
    GRID_BAR();
    { pg8::Gemm g{ACT, Wd_t, M, D, FF}; pg8::StaticOrder S; S.init(M, D, G, bid); pg8::EpiBf16<0> E{(bf16*)Y + (size_t)M * D, D, nullptr, 0, 0, 1.f};
      pg8::gemm_phase<pg8::EpiBf16<0>, pg8::StaticOrder, true, true>(lds, g, S, E); }
    GRID_BAR();
    phase_final_rows(p, gw, NGW, lane);
}

extern "C" void kernel_launch(void* const* d_in, const int* in_sizes, int n_in, void* d_out, int out_size, void* d_ws, size_t ws_size, hipStream_t stream) {
    static int grid = 0;
    if (grid == 0) {
        if (n_in != 15 || in_sizes[0] != M * D || out_size != M * D || ws_size < WS_END) { fprintf(stderr, "kernel_launch: unexpected shapes (n_in %d, in0 %d, out %d, ws %zu)\n", n_in, n_in > 0 ? in_sizes[0] : -1, out_size, ws_size); grid = -1; return; }
        int dev = 0, cus = 0, per_cu = 0;
        hipGetDevice(&dev); hipDeviceGetAttribute(&cus, hipDeviceAttributeMultiprocessorCount, dev);
        if (hipFuncSetAttribute((const void*)fwd_megakernel, hipFuncAttributeMaxDynamicSharedMemorySize, LDS_BYTES) != hipSuccess) { fprintf(stderr, "kernel_launch: hipFuncSetAttribute failed\n"); grid = -1; return; }
        if (hipOccupancyMaxActiveBlocksPerMultiprocessor(&per_cu, (const void*)fwd_megakernel, NWAVES * 64, LDS_BYTES) != hipSuccess || per_cu < 1) { fprintf(stderr, "kernel_launch: occupancy query says %d\n", per_cu); per_cu = 1; }
        (void)hipGetLastError();
        grid = cus;
    }
    if (grid < 0) return;
    if (hipMemsetAsync((char*)d_ws + WS_CTL, 0, CTL_BYTES, stream) != hipSuccess) { fprintf(stderr, "kernel_launch: memset failed\n"); return; }
    Params p{};
    p.x = (const float*)d_in[0]; p.g_pre_mix = (const float*)d_in[1]; p.w_in = (const float*)d_in[2]; p.conv_w = (const float*)d_in[3]; p.conv_b = (const float*)d_in[4];
    p.ln_g = (const float*)d_in[5]; p.ln_b = (const float*)d_in[6]; p.attn_g = (const float*)d_in[7]; p.w_out = (const float*)d_in[8]; p.g_post_mix = (const float*)d_in[9];
    p.g_pre_ffn = (const float*)d_in[10]; p.w_gate = (const float*)d_in[11]; p.w_up = (const float*)d_in[12]; p.w_down = (const float*)d_in[13]; p.g_post_ffn = (const float*)d_in[14];
    p.out = (float*)d_out; p.ws = (unsigned char*)d_ws;
    void* args[] = {&p};
    hipError_t e = hipLaunchCooperativeKernel((const void*)fwd_megakernel, dim3(grid), dim3(NWAVES * 64), args, LDS_BYTES, stream);
    if (e != hipSuccess) fprintf(stderr, "kernel_launch: cooperative launch failed: %s (grid %d)\n", hipGetErrorString(e), grid);
}
```
